# Optimizing an MI355X kernel written in HIP

```python
import math
import jax, jax.numpy as jnp
from jax import lax
import numpy as np

D_MODEL = 1024
BATCH = 8
SEQ = 2048
DEPTH = 1
DEC_BATCH = 128
DEC_SEQ = 8
PAST_LEN = 16384
PAGE_SIZE = 128

RET_HEADS = 4
RET_DK = D_MODEL // RET_HEADS
RET_DV = D_MODEL // RET_HEADS
RET_WIDTH = RET_HEADS * RET_DV
RET_CHUNK = 128
ROPE_BASE = 10000.0
CONV_DIM = D_MODEL
CONV_WIDTH = 3
MEM_LEN = 256
MEM_HEADS = 4
MEM_HEAD_DIM = D_MODEL // MEM_HEADS
MEM_WIDTH = MEM_HEADS * MEM_HEAD_DIM
N_BRANCH = 3
EPS = 1e-6
IN_SIZES = (RET_HEADS * RET_DK, RET_HEADS * RET_DK, RET_WIDTH, RET_WIDTH,
            CONV_DIM, CONV_DIM, CONV_DIM, CONV_DIM,
            MEM_WIDTH, MEM_WIDTH, N_BRANCH * D_MODEL)
IN_TOTAL = sum(IN_SIZES)

kernel_name = 'hybrid_retention_shortconv_memxattn_step'


def rms_norm(x, g):
    xf = x.astype(jnp.float32)
    y = xf * lax.rsqrt(jnp.mean(xf * xf, axis=-1, keepdims=True) + EPS)
    return (y * g.astype(jnp.float32)).astype(x.dtype)


def rotary(x, pos):
    half = x.shape[-1] // 2
    inv = ROPE_BASE ** (-jnp.arange(half, dtype=jnp.float32) / half)
    ang = pos.astype(jnp.float32)[:, None] * inv[None, :]
    cos = jnp.cos(ang)[None, :, None, :]
    sin = jnp.sin(ang)[None, :, None, :]
    xf = x.astype(jnp.float32)
    x1, x2 = xf[..., :half], xf[..., half:]
    return jnp.concatenate([x1 * cos - x2 * sin, x1 * sin + x2 * cos], axis=-1)


def retention(q, k, v, state0):
    B, L, H, _ = q.shape
    C = RET_CHUNK if L % RET_CHUNK == 0 else L
    n = L // C
    lg = jnp.log1p(-jnp.exp2(-5.0 - jnp.arange(H, dtype=jnp.float32)))
    idx = jnp.arange(C, dtype=jnp.float32)
    diff = idx[:, None] - idx[None, :]
    inner = jnp.where(diff[None] >= 0, jnp.exp(lg[:, None, None] * jnp.maximum(diff, 0.0)[None]), 0.0)
    q_dec = jnp.exp(lg[None, :] * (idx[:, None] + 1.0))
    k_dec = jnp.exp(lg[None, :] * (C - 1.0 - idx[:, None]))
    chunk_dec = jnp.exp(lg * C)

    def to_chunks(t):
        return t.reshape(B, n, C, H, t.shape[-1]).transpose(1, 0, 2, 3, 4)

    def step(S, blk):
        qc, kc, vc = blk
        s = jnp.einsum('bihd,bjhd->bhij', qc, kc) * inner[None]
        o = (jnp.einsum('bhij,bjhe->bihe', s, vc)
             + jnp.einsum('bihd,bhde->bihe', qc, S) * q_dec[None, :, :, None])
        S = (S * chunk_dec[None, :, None, None]
             + jnp.einsum('bjhd,bjhe->bhde', kc * k_dec[None, :, :, None], vc))
        return S, o

    S, o = lax.scan(step, state0, (to_chunks(q), to_chunks(k), to_chunks(v)))
    o = o.transpose(1, 0, 2, 3, 4).reshape(B, L, H, v.shape[-1])
    return o, S


def memory_kv(mem, mem_norm_g, w_mem_kv):
    B = mem.shape[0]
    kv = rms_norm(mem, mem_norm_g) @ w_mem_kv
    k, v = jnp.split(kv, 2, axis=-1)
    return (k.reshape(B, MEM_LEN, MEM_HEADS, MEM_HEAD_DIM),
            v.reshape(B, MEM_LEN, MEM_HEADS, MEM_HEAD_DIM))


def mixer_layer(x, pos, ret_state, conv_state, mem_k, mem_v,
                norm_g, w_in, b_gate, ret_norm_g, conv_w, conv_b,
                w_ret_o, w_conv_o, w_mem_o, w_out):
    B, L, _ = x.shape
    h = rms_norm(x, norm_g)
    z = h @ w_in
    (rq, rk, rv, rg, cu, cb, cc, cg, mq, mg, gl) = jnp.split(
        z, [int(o) for o in np.cumsum(IN_SIZES)[:-1]], axis=-1)

    q = rotary(rq.reshape(B, L, RET_HEADS, RET_DK), pos)
    k = rotary(rk.reshape(B, L, RET_HEADS, RET_DK), pos) * (RET_DK ** -0.5)
    v = rv.reshape(B, L, RET_HEADS, RET_DV).astype(jnp.float32)
    o, new_ret = retention(q, k, v, ret_state.astype(jnp.float32))
    o = o * lax.rsqrt(jnp.mean(o * o, axis=-1, keepdims=True) + EPS) * ret_norm_g.astype(jnp.float32)
    o = o.reshape(B, L, RET_WIDTH).astype(x.dtype) * jax.nn.silu(rg)
    y_ret = o @ w_ret_o

    pre = cc * cu
    xp = jnp.concatenate([conv_state.astype(pre.dtype), pre], axis=1)
    conv = conv_b + sum(conv_w[t] * xp[:, t:t + L] for t in range(CONV_WIDTH))
    new_conv = xp[:, L:]
    y_conv = (cb * conv * jax.nn.silu(cg)) @ w_conv_o

    qm = mq.reshape(B, L, MEM_HEADS, MEM_HEAD_DIM).astype(jnp.float32)
    s = jnp.einsum('blhd,bmhd->bhlm', qm, mem_k.astype(jnp.float32)) * (MEM_HEAD_DIM ** -0.5)
    p = jax.nn.softmax(s, axis=-1)
    om = jnp.einsum('bhlm,bmhd->blhd', p, mem_v.astype(jnp.float32))
    om = om.reshape(B, L, MEM_WIDTH).astype(x.dtype) * jax.nn.silu(mg)
    y_mem = om @ w_mem_o

    g_ret, g_conv, g_mem = jnp.split(jax.nn.sigmoid(gl + b_gate), N_BRANCH, axis=-1)
    merged = g_ret * y_ret + g_conv * y_conv + g_mem * y_mem
    y = x + merged @ w_out
    return y, new_ret.astype(x.dtype), new_conv


def setup_inputs(seed: int = 0) -> dict:
    key = jax.random.key(seed)
    ks = jax.random.split(key, 24)
    f32 = jnp.float32
    nrm = lambda k, s, sc: jax.random.normal(k, s, f32) * sc
    return {
        'x_prompt': nrm(ks[0], (BATCH, SEQ, D_MODEL), 1.0),
        'x_sample': nrm(ks[1], (DEC_BATCH, DEC_SEQ, D_MODEL), 1.0),
        'state_ret': nrm(ks[2], (DEPTH, DEC_BATCH, RET_HEADS, RET_DK, RET_DV), 0.5),
        'state_conv': nrm(ks[3], (DEPTH, DEC_BATCH, CONV_WIDTH - 1, CONV_DIM), 1.0),
        'cache_mem_k': nrm(ks[4], (DEPTH, DEC_BATCH, MEM_LEN, MEM_HEADS, MEM_HEAD_DIM), 1.0),
        'cache_mem_v': nrm(ks[5], (DEPTH, DEC_BATCH, MEM_LEN, MEM_HEADS, MEM_HEAD_DIM), 1.0),
        'mem_prompt': nrm(ks[6], (BATCH, MEM_LEN, D_MODEL), 1.0),
        'norm_g': 1.0 + nrm(ks[7], (DEPTH, D_MODEL), 0.02),
        'w_in': nrm(ks[8], (DEPTH, D_MODEL, IN_TOTAL), D_MODEL ** -0.5),
        'b_gate': nrm(ks[9], (DEPTH, N_BRANCH * D_MODEL), 0.02),
        'ret_norm_g': 1.0 + nrm(ks[10], (DEPTH, RET_HEADS, RET_DV), 0.02),
        'conv_w': nrm(ks[11], (DEPTH, CONV_WIDTH, CONV_DIM), CONV_WIDTH ** -0.5),
        'conv_b': nrm(ks[12], (DEPTH, CONV_DIM), 0.02),
        'w_ret_o': nrm(ks[13], (DEPTH, RET_WIDTH, D_MODEL), RET_WIDTH ** -0.5),
        'w_conv_o': nrm(ks[14], (DEPTH, CONV_DIM, D_MODEL), CONV_DIM ** -0.5),
        'w_mem_o': nrm(ks[15], (DEPTH, MEM_WIDTH, D_MODEL), MEM_WIDTH ** -0.5),
        'w_out': nrm(ks[16], (DEPTH, D_MODEL, D_MODEL), D_MODEL ** -0.5),
        'mem_norm_g': 1.0 + nrm(ks[17], (DEPTH, D_MODEL), 0.02),
        'w_mem_kv': nrm(ks[18], (DEPTH, D_MODEL, 2 * MEM_WIDTH), D_MODEL ** -0.5),
        'final_norm_g': 1.0 + nrm(ks[19], (D_MODEL,), 0.02),
    }


def reference(x_prompt, x_sample, state_ret, state_conv, cache_mem_k, cache_mem_v, mem_prompt,
              norm_g, w_in, b_gate, ret_norm_g, conv_w, conv_b, w_ret_o, w_conv_o, w_mem_o,
              w_out, mem_norm_g, w_mem_kv, final_norm_g):
    Bp, Lp, _ = x_prompt.shape
    Ls = x_sample.shape[1]
    pos_p = jnp.arange(Lp, dtype=jnp.int32)
    pos_s = PAST_LEN + jnp.arange(Ls, dtype=jnp.int32)
    hp, hs = x_prompt, x_sample
    ret_p, ret_s, conv_p, conv_s, mk_list, mv_list = [], [], [], [], [], []
    for l in range(DEPTH):
        mk_p, mv_p = memory_kv(mem_prompt, mem_norm_g[l], w_mem_kv[l])
        zr = jnp.zeros((Bp, RET_HEADS, RET_DK, RET_DV), x_prompt.dtype)
        zc = jnp.zeros((Bp, CONV_WIDTH - 1, CONV_DIM), x_prompt.dtype)
        hp, rp, cp = mixer_layer(hp, pos_p, zr, zc, mk_p, mv_p,
                                 norm_g[l], w_in[l], b_gate[l], ret_norm_g[l], conv_w[l], conv_b[l],
                                 w_ret_o[l], w_conv_o[l], w_mem_o[l], w_out[l])
        hs, rs, cs = mixer_layer(hs, pos_s, state_ret[l], state_conv[l], cache_mem_k[l], cache_mem_v[l],
                                 norm_g[l], w_in[l], b_gate[l], ret_norm_g[l], conv_w[l], conv_b[l],
                                 w_ret_o[l], w_conv_o[l], w_mem_o[l], w_out[l])
        ret_p.append(rp); ret_s.append(rs); conv_p.append(cp); conv_s.append(cs)
        mk_list.append(mk_p); mv_list.append(mv_p)
    y_prompt = rms_norm(hp, final_norm_g)
    y_sample = rms_norm(hs, final_norm_g)
    new_ret_prompt = jnp.stack(ret_p)
    new_ret_sample = jnp.stack(ret_s)
    new_conv_prompt = jnp.stack(conv_p)
    new_conv_sample = jnp.stack(conv_s)
    new_mem_k_prompt = jnp.stack(mk_list)
    new_mem_v_prompt = jnp.stack(mv_list)
    return (y_prompt, y_sample, new_ret_prompt, new_ret_sample, new_conv_prompt, new_conv_sample,
            new_mem_k_prompt, new_mem_v_prompt)
```

```cpp
#include <hip/hip_runtime.h>
#include <cstdio>
#include <cstdint>
#include <cmath>
#include <cstddef>

#define LAS __attribute__((address_space(3)))
#define GAS __attribute__((address_space(1)))
typedef unsigned short bf16;
typedef short bf16x8 __attribute__((ext_vector_type(8)));
typedef float f32x4 __attribute__((ext_vector_type(4)));
typedef float f32x2 __attribute__((ext_vector_type(2)));
typedef unsigned u32x4 __attribute__((ext_vector_type(4)));
typedef unsigned u32x2 __attribute__((ext_vector_type(2)));
typedef __bf16 bf16x2_t __attribute__((ext_vector_type(2)));

constexpr int D = 1024, SEQ = 2048, NB = 8, DECB = 128, DECS = 8;
constexpr int MP = NB * SEQ;
constexpr int MS = DECB * DECS;
constexpr int MT = MP + MS;
constexpr int NIN = 13 * 1024;
constexpr int NPOS = SEQ + DECS;
constexpr float EPS = 1e-6f;
constexpr float LOG2E = 1.4426950408889634f;

constexpr size_t O_Y = 0, O_RP = (size_t)MT * D, O_RS = O_RP + (size_t)NB * 4 * 65536, O_CP = O_RS + (size_t)DECB * 4 * 65536,
                 O_CS = O_CP + (size_t)NB * 2 * D, O_MK = O_CS + (size_t)DECB * 2 * D, O_MV = O_MK + (size_t)NB * 256 * D, O_END = O_MV + (size_t)NB * 256 * D;

constexpr size_t MiB = 1u << 20;
constexpr size_t WS_CTL = 0, CTL_ZERO_BYTES = 1 * MiB;
constexpr size_t WS_COS = 1 * MiB, WS_SIN = 2 * MiB + 512 * 1024;
constexpr size_t WS_WRO = 4 * MiB, WS_WCO = 6 * MiB, WS_WMO = 8 * MiB, WS_WOUT = 10 * MiB, WS_WMKV = 12 * MiB, WS_WIN = 16 * MiB;
constexpr size_t WS_MN = 42 * MiB, WS_MKB = 46 * MiB, WS_MVT = 50 * MiB;
constexpr size_t WS_H = 54 * MiB;
constexpr size_t WS_Q = 88 * MiB;
constexpr size_t WS_KT = 122 * MiB;
constexpr size_t WS_KTT = 156 * MiB;
constexpr size_t WS_VT = 190 * MiB;
constexpr size_t WS_VS = 222 * MiB;
constexpr size_t WS_RG = 224 * MiB;
constexpr size_t WS_PRE = 258 * MiB;
constexpr size_t WS_GCB = 292 * MiB;
constexpr size_t WS_MQ = 326 * MiB;
constexpr size_t WS_MG = 360 * MiB;
constexpr size_t WS_GATES = 394 * MiB;
constexpr size_t WS_SALL = 496 * MiB;
constexpr size_t WS_END = 528 * MiB;

constexpr int CW_BAR = 4096;
constexpr int CW_QUEUE = 8192;
constexpr int CW_ROWSS = 16384;

constexpr int LDS_BYTES = 163840, LDS_X = 131072, LDS_MISC = LDS_BYTES - 256;
constexpr int NWAVES = 8;

__device__ __forceinline__ unsigned pk2(float lo, float hi) { f32x2 v = {lo, hi}; bf16x2_t b = __builtin_convertvector(v, bf16x2_t); return __builtin_bit_cast(unsigned, b); }
__device__ __forceinline__ float bflo(unsigned w) { return __uint_as_float(w << 16); }
__device__ __forceinline__ float bfhi(unsigned w) { return __uint_as_float(w & 0xffff0000u); }
__device__ __forceinline__ u32x4 pack8(f32x4 a, f32x4 b) { u32x4 w; w.x = pk2(a[0], a[1]); w.y = pk2(a[2], a[3]); w.z = pk2(b[0], b[1]); w.w = pk2(b[2], b[3]); return w; }
__device__ __forceinline__ void unpack8(u32x4 w, f32x4& a, f32x4& b) { a = (f32x4){bflo(w.x), bfhi(w.x), bflo(w.y), bfhi(w.y)}; b = (f32x4){bflo(w.z), bfhi(w.z), bflo(w.w), bfhi(w.w)}; }
__device__ __forceinline__ float sigm(float x) { return __builtin_amdgcn_rcpf(1.0f + __builtin_amdgcn_exp2f(-LOG2E * x)); }
__device__ __forceinline__ f32x4 sigm4(f32x4 x) { return (f32x4){sigm(x[0]), sigm(x[1]), sigm(x[2]), sigm(x[3])}; }
__device__ __forceinline__ f32x4 silu4(f32x4 x) { return x * sigm4(x); }
__device__ __forceinline__ float wave_sum(float v) {
#pragma unroll
    for (int o = 1; o < 64; o <<= 1) v += __shfl_xor(v, o);
    return v;
}
__device__ __forceinline__ float wave_max(float v) {
#pragma unroll
    for (int o = 1; o < 64; o <<= 1) v = fmaxf(v, __shfl_xor(v, o));
    return v;
}
#define LDS_WAIT() asm volatile("s_waitcnt lgkmcnt(0)" ::: "memory")
#define VM_WAIT() asm volatile("s_waitcnt vmcnt(0)" ::: "memory")

struct Params {
    const float* in[20]; float* out; unsigned char* ws;
    float clog[4];
    int ph_lo, ph_hi;
};
static_assert(sizeof(Params) == 200 && offsetof(Params, clog) == 176, "Params layout (the kernel reads it through the kernarg segment pointer)");
typedef const __attribute__((address_space(4))) unsigned long long* kargp_t;
struct Bufs {
    kargp_t ka; unsigned char* ws; float* out;
    __device__ __forceinline__ const float* in(int i) const { return (const float*)ka[i]; }
    __device__ __forceinline__ float clg(int h) const { return __builtin_bit_cast(f32x2, ka[22 + (h >> 1)])[h & 1]; }
#define BUF_IN(name, i) __device__ __forceinline__ const float* name() const { return in(i); }
    BUF_IN(xp, 0) BUF_IN(xs, 1) BUF_IN(state_ret, 2) BUF_IN(state_conv, 3) BUF_IN(cmk, 4) BUF_IN(cmv, 5) BUF_IN(memp, 6) BUF_IN(norm_g, 7) BUF_IN(w_in, 8) BUF_IN(b_gate, 9)
    BUF_IN(ret_g, 10) BUF_IN(conv_w, 11) BUF_IN(conv_b, 12) BUF_IN(w_ro, 13) BUF_IN(w_co, 14) BUF_IN(w_mo, 15) BUF_IN(w_out, 16) BUF_IN(memn_g, 17) BUF_IN(w_mkv, 18) BUF_IN(fin_g, 19)
#undef BUF_IN
#define BUF_WS(T, name, off) __device__ __forceinline__ T* name() const { return (T*)(ws + (off)); }
    BUF_WS(unsigned, ctl, WS_CTL) BUF_WS(float, cosT, WS_COS) BUF_WS(float, sinT, WS_SIN)
    BUF_WS(bf16, Wro, WS_WRO) BUF_WS(bf16, Wco, WS_WCO) BUF_WS(bf16, Wmo, WS_WMO) BUF_WS(bf16, Wout, WS_WOUT) BUF_WS(bf16, Wmkv, WS_WMKV) BUF_WS(bf16, Win, WS_WIN)
    BUF_WS(bf16, MN, WS_MN) BUF_WS(bf16, MKb, WS_MKB) BUF_WS(bf16, MVt, WS_MVT) BUF_WS(bf16, H, WS_H) BUF_WS(bf16, Q, WS_Q) BUF_WS(bf16, KT, WS_KT) BUF_WS(bf16, KTt, WS_KTT)
    BUF_WS(bf16, Vt, WS_VT) BUF_WS(bf16, Vs, WS_VS) BUF_WS(bf16, RG, WS_RG) BUF_WS(bf16, PRE, WS_PRE) BUF_WS(bf16, GCB, WS_GCB) BUF_WS(bf16, MQ, WS_MQ) BUF_WS(bf16, MG, WS_MG)
    BUF_WS(bf16, GATES, WS_GATES) BUF_WS(bf16, SALL, WS_SALL)
#undef BUF_WS
};

namespace pg8 {
constexpr int BM = 256, BK = 64, HALF = 128, HTB = HALF * BK * 2, STAGE_BYTES = 8 * HTB;
__host__ __device__ __forceinline__ int lds_byte(int r, int c) { const int st = (r >> 4) * 2 + (c >> 5), rr = r & 15, cc = c & 31, ob = rr * 64 + cc * 2; return st * 1024 + (ob ^ (((ob >> 9) & 1) << 5)); }
__host__ __device__ __forceinline__ void stage_rc(int b, int& R, int& C) { const int st = b / 1024, sb = b % 1024, swz = sb ^ (((sb >> 9) & 1) << 5); R = (st >> 1) * 16 + swz / 64; C = (st & 1) * 32 + (swz % 64) / 2; }
__host__ __device__ __forceinline__ int perm32(int rho) { const int n = rho >> 4, i = rho & 15; return 8 * (i >> 2) + 4 * n + (i & 3); }

enum Kind { K_RQ = 0, K_RK, K_RV, K_RVT, K_RG, K_CA, K_CB, K_MQ, K_MG, K_GL, K_MK, K_MVT, K_QK, K_CHAIN, K_XS, K_RETO, K_XO, K_P3A, K_P3B };
struct Unit {
    const char* A; const char* B;
    unsigned lda, ldb;
    unsigned meta;
    unsigned pmn;
    __device__ __forceinline__ int kind() const { return (int)(meta & 31u); }
    __device__ __forceinline__ int aux() const { return (int)((meta >> 6) & 3u); }
    __device__ __forceinline__ int nt() const { return (int)((meta >> 8) & 255u); }
    __device__ __forceinline__ bool keep() const { return (meta & 32u) != 0u; }
    __device__ __forceinline__ int pm() const { return (int)(pmn & 0xffffu); }
    __device__ __forceinline__ int pn() const { return (int)(pmn >> 16); }
    __device__ __forceinline__ void set(int kind, int pm, int pn, int nt = 16, int aux = 0, int keep = 0) { meta = (unsigned)kind | ((unsigned)keep << 5) | ((unsigned)aux << 6) | ((unsigned)nt << 8); pmn = (unsigned)pm | ((unsigned)pn << 16); }
};

template <class Sched, class Epi>
__device__ __forceinline__ void gemm_phase(LAS unsigned char* lds, const Sched& S, const Epi& E) {
    const int tid = threadIdx.x, wid = __builtin_amdgcn_readfirstlane(tid >> 6), lane = tid & 63, wr = wid >> 2, wc = wid & 3, fr = lane & 15, fq = lane >> 4;
    unsigned Ra0, Rb0, Cc0;
    { int R, C; stage_rc(tid * 16, R, C); Ra0 = (unsigned)R; Rb0 = (unsigned)((R & ~31) + perm32(R & 31)); Cc0 = (unsigned)C * 2u; }
    const unsigned ldsw = (unsigned)wid * 1024u;
    const int aoff = lds_byte(wr * 64 + fr, fq * 8), boff = lds_byte(wc * 32 + fr, fq * 8);
#define PG8_SA(b, h) (((b) * 2 + (h)) * HTB)
#define PG8_SB(b, h) ((4 + (b) * 2 + (h)) * HTB)
#define PG8_STAGE(bufoff, gbase, R0, ld) do { const unsigned _v = (R0) * (ld) + Cc0; const char* _g = (const char*)(gbase); \
        __builtin_amdgcn_global_load_lds((const unsigned*)(_g + _v), (LAS unsigned*)(lds + (bufoff) + ldsw), 16, 0, 0); \
        __builtin_amdgcn_global_load_lds((const unsigned*)(_g + 64u * (ld) + _v), (LAS unsigned*)(lds + (bufoff) + ldsw + 8192), 16, 0, 0); } while (0)
#define PG8_STA(bufoff, gbase, ld) PG8_STAGE(bufoff, gbase, Ra0, ld)
#define PG8_STB(bufoff, gbase, ld) PG8_STAGE(bufoff, gbase, Rb0, ld)
#define PG8_LDA(dst, b, h) do { _Pragma("unroll") for (int m = 0; m < 4; ++m) _Pragma("unroll") for (int k = 0; k < 2; ++k) dst[m][k] = *(const LAS bf16x8*)(lds + PG8_SA(b, h) + aoff + m * 2048 + k * 1024); } while (0)
#define PG8_LDB(dst, b, h) do { _Pragma("unroll") for (int n = 0; n < 2; ++n) _Pragma("unroll") for (int k = 0; k < 2; ++k) dst[n][k] = *(const LAS bf16x8*)(lds + PG8_SB(b, h) + boff + n * 2048 + k * 1024); } while (0)
#define PG8_MMA(ai, bj, At, Bt) do { __builtin_amdgcn_s_setprio(1); _Pragma("unroll") for (int m = 0; m < 4; ++m) _Pragma("unroll") for (int n = 0; n < 2; ++n) _Pragma("unroll") for (int k = 0; k < 2; ++k) \
        acc[ai][bj][m][n] = __builtin_amdgcn_mfma_f32_16x16x32_bf16(Bt[n][k], At[m][k], acc[ai][bj][m][n], 0, 0, 0); __builtin_amdgcn_s_setprio(0); } while (0)
#define PG8_WAIT_V(n) asm volatile("s_waitcnt vmcnt(" #n ")" ::: "memory")
#define PG8_WAIT_L(n) asm volatile("s_waitcnt lgkmcnt(" #n ")" ::: "memory")
#define PG8_BAR __builtin_amdgcn_s_barrier()
#define PG8_SCHED __builtin_amdgcn_sched_barrier(0)
#define PG8_PA(u, tt) ((u).A + (unsigned)(tt) * 128u + (((tt) >= 4 && (u).kind() == K_RETO) ? (long long)(WS_Q - WS_H) - 512 : 0ll))
#define PG8_PB(u, tt) ((u).B + (unsigned)(tt) * 128u + (((tt) >= 4 && (u).kind() == K_RETO) ? (long long)(WS_SALL - WS_VT) - 512 : 0ll))
    Unit cur; int ui = 0;
    if (!S.next(0, cur)) return;
    f32x4 acc[2][2][4][2];
#pragma unroll
    for (int a = 0; a < 2; ++a)
#pragma unroll
        for (int b = 0; b < 2; ++b)
#pragma unroll
            for (int m = 0; m < 4; ++m)
#pragma unroll
                for (int n = 0; n < 2; ++n) acc[a][b][m][n] = (f32x4){0.f, 0.f, 0.f, 0.f};
    bf16x8 At[4][2], B0[2][2], B1[2][2];
    {
        const char* cA = cur.A; const char* cB = cur.B; const unsigned la = cur.lda, lb = cur.ldb;
        PG8_STB(PG8_SB(0, 0), cB, lb); PG8_STB(PG8_SB(0, 1), cB + 128u * lb, lb); PG8_STA(PG8_SA(0, 0), cA, la); PG8_STA(PG8_SA(0, 1), cA + 128u * la, la);
        if (wr == 1) PG8_BAR;
        PG8_WAIT_V(2); PG8_BAR;
        PG8_STB(PG8_SB(1, 0), cB + 128, lb); PG8_STA(PG8_SA(1, 0), cA + 128, la); PG8_STB(PG8_SB(1, 1), cB + 128u * lb + 128, lb);
        PG8_WAIT_V(6); PG8_BAR;
    }
    for (;;) {
        const char* nA; const char* nB; unsigned nla, nlb; bool has_next;
        { Unit nx; has_next = S.next(ui + 1, nx); if (!has_next) nx = cur;
          nA = nx.A; nB = nx.B; nla = nx.lda; nlb = nx.ldb; }
        const int nt = cur.nt(); const unsigned cla = cur.lda, clb = cur.ldb;
        for (int t = 0; t < nt; t += 2) {
            const bool last = (t == nt - 2);
            const unsigned la2 = last ? nla : cla, lb2 = last ? nlb : clb;
            PG8_LDB(B0, 0, 0); PG8_LDB(B1, 0, 1); PG8_SCHED; PG8_LDA(At, 0, 0);
            { const char* a1 = PG8_PA(cur, t + 1); PG8_STA(PG8_SA(1, 1), a1 + 128u * cla, cla); }
            PG8_WAIT_V(8); PG8_WAIT_L(0); PG8_BAR; PG8_MMA(0, 0, At, B0); PG8_MMA(0, 1, At, B1); PG8_BAR; PG8_SCHED;
            PG8_LDA(At, 0, 1);
            { const char* a2 = last ? nA : PG8_PA(cur, t + 2); const char* b2 = last ? nB : PG8_PB(cur, t + 2);
              PG8_STB(PG8_SB(0, 0), b2, lb2); PG8_STB(PG8_SB(0, 1), b2 + 128u * lb2, lb2); PG8_STA(PG8_SA(0, 0), a2, la2); }
            PG8_WAIT_V(8); PG8_WAIT_L(0); PG8_BAR; PG8_MMA(1, 0, At, B0); PG8_MMA(1, 1, At, B1); PG8_BAR; PG8_SCHED;
            PG8_LDB(B0, 1, 0); PG8_LDB(B1, 1, 1); PG8_SCHED; PG8_LDA(At, 1, 0);
            { const char* a2 = last ? nA : PG8_PA(cur, t + 2); PG8_STA(PG8_SA(0, 1), a2 + 128u * la2, la2); }
            PG8_WAIT_V(8); PG8_WAIT_L(0); PG8_BAR; PG8_MMA(0, 0, At, B0); PG8_MMA(0, 1, At, B1); PG8_BAR; PG8_SCHED;
            PG8_LDA(At, 1, 1);
            { const char* a3 = last ? nA + 128 : PG8_PA(cur, t + 3); const char* b3 = last ? nB + 128 : PG8_PB(cur, t + 3);
              PG8_STB(PG8_SB(1, 0), b3, lb2); PG8_STB(PG8_SB(1, 1), b3 + 128u * lb2, lb2); PG8_STA(PG8_SA(1, 0), a3, la2); }
            PG8_WAIT_V(8); PG8_WAIT_L(0); PG8_BAR; PG8_MMA(1, 0, At, B0); PG8_MMA(1, 1, At, B1); PG8_BAR; PG8_SCHED;
        }
        if (wr == 0) PG8_BAR;
        E(acc, cur, wr, wc, fr, fq, lds);
        if (!has_next) break;
        if (!cur.keep()) {
#pragma unroll
            for (int a = 0; a < 2; ++a)
#pragma unroll
                for (int b = 0; b < 2; ++b)
#pragma unroll
                    for (int m = 0; m < 4; ++m)
#pragma unroll
                        for (int n = 0; n < 2; ++n) acc[a][b][m][n] = (f32x4){0.f, 0.f, 0.f, 0.f};
        }
        ++ui; (void)S.next(ui, cur);
        if (wr == 1) PG8_BAR;
    }
    PG8_WAIT_V(0);
    PG8_BAR;
#undef PG8_SA
#undef PG8_SB
#undef PG8_STAGE
#undef PG8_STA
#undef PG8_STB
#undef PG8_LDA
#undef PG8_LDB
#undef PG8_MMA
#undef PG8_WAIT_V
#undef PG8_WAIT_L
#undef PG8_BAR
#undef PG8_SCHED
#undef PG8_PA
#undef PG8_PB
}
}
using pg8::Unit;

template <int PH> struct Sched {
    static constexpr int ph = PH; int G, c; Bufs b;
    __device__ __forceinline__ bool next(int i, Unit& u) const {
        u.lda = 2048; u.ldb = 2048;
        if constexpr (PH == 1) {
            const int L = i * G + c; constexpr int NW1 = 68 * 52;
            if (L >= NW1 + 64) return false;
            if (L < NW1) {
                const int q = NW1 / 8, xcd = L % 8, off = L / 8; const int wg = xcd * q + off;
                const int nig = 8 * 52, gid = wg / nig, fm = gid * 8, gsz = (68 - fm) < 8 ? (68 - fm) : 8;
                const int pm = fm + ((wg % nig) % gsz), pn = (wg % nig) / gsz;
                const char* hrow = (const char*)b.H() + (size_t)pm * 256 * 2048; const char* wrow = (const char*)b.Win() + (size_t)pn * 256 * 2048;
                u.A = hrow; u.B = wrow; int kind;
                if (pn < 4) kind = pg8::K_RQ; else if (pn < 8) kind = pg8::K_RK;
                else if (pn < 12) { if (pm < 64) { kind = pg8::K_RVT; u.A = wrow; u.B = hrow; } else kind = pg8::K_RV; }
                else if (pn < 16) kind = pg8::K_RG; else if (pn < 24) kind = pg8::K_CA; else if (pn < 32) kind = pg8::K_CB;
                else if (pn < 36) kind = pg8::K_MQ; else if (pn < 40) kind = pg8::K_MG; else kind = pg8::K_GL;
                u.set(kind, pm, pn);
            } else {
                const int j = L - NW1, bb = j >> 3, pn = j & 7;
                const char* mrow = (const char*)b.MN() + (size_t)bb * 256 * 2048; const char* wrow = (const char*)b.Wmkv() + (size_t)pn * 256 * 2048;
                if (pn < 4) { u.set(pg8::K_MK, bb, pn); u.A = mrow; u.B = wrow; } else { u.set(pg8::K_MVT, bb, pn); u.A = wrow; u.B = mrow; }
            }
            return true;
        }
        if constexpr (PH == 20) {
            if (c >= 32 || i >= 8) return false;
            u.set(pg8::K_CHAIN, c, i, 4, 0, i < 7 ? 1 : 0); u.lda = 4096; u.ldb = 4096;
            u.A = (const char*)b.Vt() + ((size_t)c * 256 * 2048 + (size_t)i * 256) * 2; u.B = (const char*)b.KTt() + ((size_t)c * 256 * 2048 + (size_t)i * 256) * 2; return true;
        }
        if constexpr (PH == 21 || PH == 22) {
            if (c < 32) return false;
            const int L = i * (G - 32) + (c - 32); if (L >= 256) return false;
            const int bh = L >> 3, cc = L & 7, bb = bh >> 2, h = bh & 3;
            const size_t off = ((size_t)(bb * SEQ + cc * 256) * D + h * 256) * 2;
            if constexpr (PH == 21) { u.set(pg8::K_QK, bh, cc, 4); u.A = (const char*)b.Q() + off; u.B = (const char*)b.KT() + off; }
            else { u.set(pg8::K_XS, bh, cc, 4); u.A = (const char*)b.MQ() + off; u.B = (const char*)b.MKb() + ((size_t)(bb * 256) * D + h * 256) * 2; }
            return true;
        }
        if constexpr (PH == 3) {
            const int L = i * G + c; if (L >= 512) return false;
            const int j = L & 255, bh = j >> 3, cc = j & 7, bb = bh >> 2, h = bh & 3;
            const size_t off = ((size_t)(bb * SEQ + cc * 256) * D + h * 256) * 2;
            if (L < 256) { u.set(pg8::K_RETO, bh, cc, cc == 0 ? 4 : 8); u.ldb = 4096;
                u.A = (const char*)b.H() + off; u.B = (const char*)b.Vt() + ((size_t)bh * 256 * 2048 + (size_t)cc * 256) * 2; }
            else { u.set(pg8::K_XO, bh, cc, 4); u.ldb = 512; u.A = (const char*)b.MQ() + off; u.B = (const char*)b.MVt() + (size_t)bh * 256 * 256 * 2; }
            return true;
        }
        if constexpr (PH == 4) {
            const int tile = (i / 3) * G + c, br = i % 3; if (tile >= 272) return false;
            int pm, pn; if (tile < 256) { const int x = tile & 7, idx = tile >> 3; pm = x * 8 + (idx >> 2); pn = idx & 3; } else { pm = 64 + ((tile - 256) >> 2); pn = (tile - 256) & 3; }
            u.set(pg8::K_P3A, pm, pn, 16, br);
            const bf16* a = br == 0 ? b.Q() : (br == 1 ? b.GCB() : b.MQ()); const bf16* w = br == 0 ? b.Wro() : (br == 1 ? b.Wco() : b.Wmo());
            u.A = (const char*)a + (size_t)pm * 256 * 2048; u.B = (const char*)w + (size_t)pn * 256 * 2048; return true;
        }
        if constexpr (PH == 5) {
            const int tile = i * G + c; if (tile >= 272) return false;
            int pm, pn; if (tile < 256) { const int x = tile & 7, idx = tile >> 3; pm = x * 8 + (idx >> 2); pn = idx & 3; } else { pm = 64 + ((tile - 256) >> 2); pn = (tile - 256) & 3; }
            u.set(pg8::K_P3B, pm, pn);
            u.A = (const char*)b.H() + (size_t)pm * 256 * 2048; u.B = (const char*)b.Wout() + (size_t)pn * 256 * 2048; return true;
        }
        return false;
    }
};

template <int PH> struct Epi {
    Bufs bufs;
    typedef f32x4 Acc[2][2][4][2];
#define EROW(ai, m) (128 * (ai) + 64 * wr + 16 * (m) + fr)
    template <bool ISK> __device__ __forceinline__ void rope(Acc& acc, const Unit& u, int wr, int wc, int fr, int fq) const {
        const Bufs& b = bufs; const int head = u.pn() & 3, cl = 32 * wc + 8 * fq; const float ch = b.clg(head); const bool prompt = u.pm() < 64;
#pragma unroll
        for (int ai = 0; ai < 2; ++ai)
#pragma unroll
            for (int m = 0; m < 4; ++m) { __builtin_amdgcn_sched_barrier(0);
                const int r = u.pm() * 256 + EROW(ai, m);
                const int pidx = prompt ? (r & (SEQ - 1)) : SEQ + (r & 7);
                const float* cp = b.cosT() + pidx * 128 + cl; const float* sp = b.sinT() + pidx * 128 + cl;
                const f32x4 c0 = *(const f32x4*)cp, c1 = *(const f32x4*)(cp + 4), s0 = *(const f32x4*)sp, s1 = *(const f32x4*)(sp + 4);
                const f32x4 x1a = acc[ai][0][m][0], x1b = acc[ai][0][m][1], x2a = acc[ai][1][m][0], x2b = acc[ai][1][m][1];
                f32x4 o1a = x1a * c0 - x2a * s0, o1b = x1b * c1 - x2b * s1, o2a = x1a * s0 + x2a * c0, o2b = x1b * s1 + x2b * c1;
                if (ISK) { float sc = 0.0625f; if (prompt) sc *= __builtin_amdgcn_exp2f((float)((r & 255) + 1) * ch); o1a *= sc; o1b *= sc; o2a *= sc; o2b *= sc; }
                bf16* dst = (ISK ? b.KT() : b.Q()) + (size_t)r * D + head * 256 + cl;
                const u32x4 w1 = pack8(o1a, o1b), w2 = pack8(o2a, o2b);
                *(u32x4*)dst = w1; *(u32x4*)(dst + 128) = w2;
                if (ISK && prompt) {
                    const float s2 = __builtin_amdgcn_exp2f((float)((r & (SEQ - 1)) & ~255) * ch);
                    const u32x4 t1 = pack8(o1a * s2, o1b * s2), t2 = pack8(o2a * s2, o2b * s2);
                    bf16* t = b.KTt() + ((size_t)(((r >> 11) * 4 + head) * 256 + cl)) * SEQ + (r & (SEQ - 1));
#pragma unroll
                    for (int e = 0; e < 8; ++e) { t[(size_t)e * SEQ] = (bf16)(t1[e >> 1] >> (16 * (e & 1))); t[(size_t)(128 + e) * SEQ] = (bf16)(t2[e >> 1] >> (16 * (e & 1))); }
                }
            }
    }
    template <int MODE> __device__ __forceinline__ void store_tile(Acc& acc, bf16* base  , size_t ld, const float* bias, int wr, int wc, int fr, int fq) const {
        const int cl = 32 * wc + 8 * fq;
#pragma unroll
        for (int ai = 0; ai < 2; ++ai)
#pragma unroll
            for (int m = 0; m < 4; ++m) { __builtin_amdgcn_sched_barrier(0); bf16* rowp = base + (size_t)EROW(ai, m) * ld + cl;
#pragma unroll
                for (int bj = 0; bj < 2; ++bj) { f32x4 v0 = acc[ai][bj][m][0], v1 = acc[ai][bj][m][1];
                    if (MODE == 1) { v0 = silu4(v0); v1 = silu4(v1); }
                    if (MODE == 2) { const f32x4 b0 = *(const f32x4*)(bias + 128 * bj + cl), b1 = *(const f32x4*)(bias + 128 * bj + cl + 4); v0 = sigm4(v0 + b0); v1 = sigm4(v1 + b1); }
                    *(u32x4*)(rowp + 128 * bj) = pack8(v0, v1); } }
    }
    __device__ __forceinline__ void operator()(Acc& acc, const Unit& u, int wr, int wc, int fr, int fq, LAS unsigned char* lds) const {
        asm volatile("" : "+v"(fr), "+v"(fq), "+s"(wr), "+s"(wc));
        const Bufs& b = bufs; const int cl = 32 * wc + 8 * fq;
        switch (u.kind()) {
        case pg8::K_RQ: if constexpr (PH == 1) { rope<false>(acc, u, wr, wc, fr, fq); } break;
        case pg8::K_RK: if constexpr (PH == 1) { rope<true>(acc, u, wr, wc, fr, fq); } break;
        case pg8::K_RV: if constexpr (PH == 1) { store_tile<0>(acc, b.Vs() + (size_t)(u.pm() * 256 - MP) * D + (u.pn() - 8) * 256, D, nullptr, wr, wc, fr, fq); } break;
        case pg8::K_RVT: if constexpr (PH == 1) { store_tile<0>(acc, b.Vt() + (size_t)(((u.pm() >> 3) * 4 + (u.pn() - 8)) * 256) * SEQ + (u.pm() & 7) * 256, SEQ, nullptr, wr, wc, fr, fq); } break;
        case pg8::K_RG: if constexpr (PH == 1) { store_tile<1>(acc, b.RG() + (size_t)u.pm() * 256 * D + (u.pn() - 12) * 256, D, nullptr, wr, wc, fr, fq); } break;
        case pg8::K_MQ: if constexpr (PH == 1) { store_tile<0>(acc, b.MQ() + (size_t)u.pm() * 256 * D + (u.pn() - 32) * 256, D, nullptr, wr, wc, fr, fq); } break;
        case pg8::K_MG: if constexpr (PH == 1) { store_tile<1>(acc, b.MG() + (size_t)u.pm() * 256 * D + (u.pn() - 36) * 256, D, nullptr, wr, wc, fr, fq); } break;
        case pg8::K_GL: if constexpr (PH == 1) { const int gi = u.pn() - 40; store_tile<2>(acc, b.GATES() + (size_t)(gi >> 2) * MT * D + (size_t)u.pm() * 256 * D + (gi & 3) * 256, D, b.b_gate() + gi * 256, wr, wc, fr, fq); } break;
        case pg8::K_CA: if constexpr (PH == 1) {
            const int t = u.pn() - 16;
#pragma unroll
            for (int ai = 0; ai < 2; ++ai)
#pragma unroll
                for (int m = 0; m < 4; ++m) { __builtin_amdgcn_sched_barrier(0); const int r = u.pm() * 256 + EROW(ai, m);
                    const f32x4 p0 = acc[ai][0][m][0] * acc[ai][1][m][0], p1 = acc[ai][0][m][1] * acc[ai][1][m][1];
                    *(u32x4*)(b.PRE() + (size_t)r * D + 128 * t + cl) = pack8(p0, p1);
                    float* st = nullptr;
                    if (u.pm() < 64) { const int tt = r & (SEQ - 1); if (tt >= SEQ - 2) st = b.out + O_CP + (size_t)((r >> 11) * 2 + (tt - (SEQ - 2))) * D; }
                    else { const int rs = r - MP, tt = rs & 7; if (tt >= 6) st = b.out + O_CS + (size_t)((rs >> 3) * 2 + (tt - 6)) * D; }
                    if (st) { *(f32x4*)(st + 128 * t + cl) = p0; *(f32x4*)(st + 128 * t + cl + 4) = p1; } }
        } break;
        case pg8::K_CB: if constexpr (PH == 1) {
            const int t = u.pn() - 24;
#pragma unroll
            for (int ai = 0; ai < 2; ++ai)
#pragma unroll
                for (int m = 0; m < 4; ++m) { __builtin_amdgcn_sched_barrier(0); const int r = u.pm() * 256 + EROW(ai, m);
                    *(u32x4*)(b.GCB() + (size_t)r * D + 128 * t + cl) = pack8(acc[ai][0][m][0] * silu4(acc[ai][1][m][0]), acc[ai][0][m][1] * silu4(acc[ai][1][m][1])); }
        } break;
        case pg8::K_MK: if constexpr (PH == 1) {
#pragma unroll
            for (int ai = 0; ai < 2; ++ai)
#pragma unroll
                for (int m = 0; m < 4; ++m) { __builtin_amdgcn_sched_barrier(0); const size_t ro = (size_t)(u.pm() * 256 + EROW(ai, m)) * D + u.pn() * 256 + cl;
#pragma unroll
                    for (int bj = 0; bj < 2; ++bj) { const f32x4 v0 = acc[ai][bj][m][0], v1 = acc[ai][bj][m][1];
                        *(f32x4*)(b.out + O_MK + ro + 128 * bj) = v0; *(f32x4*)(b.out + O_MK + ro + 128 * bj + 4) = v1; *(u32x4*)(b.MKb() + ro + 128 * bj) = pack8(v0, v1); } }
        } break;
        case pg8::K_MVT: if constexpr (PH == 1) {
            const int h = u.pn() - 4;
#pragma unroll
            for (int ai = 0; ai < 2; ++ai)
#pragma unroll
                for (int m = 0; m < 4; ++m) { __builtin_amdgcn_sched_barrier(0); const int f = EROW(ai, m);
#pragma unroll
                    for (int bj = 0; bj < 2; ++bj) { const f32x4 v0 = acc[ai][bj][m][0], v1 = acc[ai][bj][m][1]; const int mm = 128 * bj + cl;
                        *(u32x4*)(b.MVt() + (size_t)((u.pm() * 4 + h) * 256 + f) * 256 + mm) = pack8(v0, v1);
                        float* o = b.out + O_MV + (size_t)(u.pm() * 256 + mm) * D + h * 256 + f;
#pragma unroll
                        for (int e = 0; e < 4; ++e) { o[(size_t)e * D] = v0[e]; o[(size_t)(4 + e) * D] = v1[e]; } } }
        } break;
        case pg8::K_QK: if constexpr (PH == 21) {
            const int bh = u.pm(), bb = bh >> 2, h = bh & 3;
#pragma unroll
            for (int ai = 0; ai < 2; ++ai)
#pragma unroll
                for (int m = 0; m < 4; ++m) { __builtin_amdgcn_sched_barrier(0); const int il = EROW(ai, m); bf16* rowp = b.H() + (size_t)(bb * SEQ + u.pn() * 256 + il) * D + h * 256 + cl;
#pragma unroll
                    for (int bj = 0; bj < 2; ++bj) { f32x4 v0 = acc[ai][bj][m][0], v1 = acc[ai][bj][m][1]; const int j0 = 128 * bj + cl;
                        const int dd = il - j0;
#pragma unroll
                        for (int e = 0; e < 4; ++e) { v0[e] *= (float)min(max(dd - e + 1, 0), 1); v1[e] *= (float)min(max(dd - e - 3, 0), 1); }
                        *(u32x4*)(rowp + 128 * bj) = pack8(v0, v1); }
                    asm volatile("" ::: "memory"); }
        } break;
        case pg8::K_CHAIN: if constexpr (PH == 20) {
            const int bh = u.pm(), h = bh & 3, step = u.pn(); const float gs = __builtin_amdgcn_exp2f(-256.0f * (float)(step + 1) * b.clg(h));
#pragma unroll
            for (int ai = 0; ai < 2; ++ai)
#pragma unroll
                for (int m = 0; m < 4; ++m) { __builtin_amdgcn_sched_barrier(0); const int f = EROW(ai, m);
#pragma unroll
                    for (int bj = 0; bj < 2; ++bj) { const f32x4 v0 = acc[ai][bj][m][0] * gs, v1 = acc[ai][bj][m][1] * gs; const int dk = 128 * bj + cl;
                        if (step < 7) *(u32x4*)(b.SALL() + (size_t)(bh * 256 + f) * SEQ + (step + 1) * 256 + dk) = pack8(v0, v1);
                        else { float* o = b.out + O_RP + (size_t)(bh * 256 + dk) * 256 + f;
#pragma unroll
                            for (int e = 0; e < 4; ++e) { o[(size_t)e * 256] = v0[e]; o[(size_t)(4 + e) * 256] = v1[e]; } } } }
        } break;
        case pg8::K_RETO: if constexpr (PH == 3) {
            const int bh = u.pm(), bb = bh >> 2, h = bh & 3; const float ch = b.clg(h);
            LAS float* X = (LAS float*)(lds + LDS_X);
            float rs[2][4];
#pragma unroll
            for (int ai = 0; ai < 2; ++ai)
#pragma unroll
                for (int m = 0; m < 4; ++m) { __builtin_amdgcn_sched_barrier(0); const int il = EROW(ai, m); const float sc = __builtin_amdgcn_exp2f(-(float)(il + 1) * ch); float ss = 0.f;
#pragma unroll
                    for (int bj = 0; bj < 2; ++bj)
#pragma unroll
                        for (int n = 0; n < 2; ++n) { f32x4 v = acc[ai][bj][m][n] * sc; acc[ai][bj][m][n] = v; ss += (v[0] * v[0] + v[1] * v[1]) + (v[2] * v[2] + v[3] * v[3]); }
                    ss += __shfl_xor(ss, 16); ss += __shfl_xor(ss, 32);
                    if (fq == 0) X[il * 4 + wc] = ss; }
            LDS_WAIT(); __builtin_amdgcn_s_barrier(); asm volatile("" ::: "memory");
#pragma unroll
            for (int ai = 0; ai < 2; ++ai)
#pragma unroll
                for (int m = 0; m < 4; ++m) { __builtin_amdgcn_sched_barrier(0); const int il = EROW(ai, m); const f32x4 t = *(const LAS f32x4*)(X + il * 4); rs[ai][m] = __builtin_amdgcn_rsqf(((t[0] + t[1]) + (t[2] + t[3])) * (1.0f / 256.0f) + EPS); }
#pragma unroll
            for (int ai = 0; ai < 2; ++ai)
#pragma unroll
                for (int m = 0; m < 4; ++m) { __builtin_amdgcn_sched_barrier(0); const int il = EROW(ai, m); const size_t ro = (size_t)(bb * SEQ + u.pn() * 256 + il) * D + h * 256 + cl;
#pragma unroll
                    for (int bj = 0; bj < 2; ++bj) { const float* gp = b.ret_g() + h * 256 + 128 * bj + cl; const f32x4 g0 = *(const f32x4*)gp, g1 = *(const f32x4*)(gp + 4);
                        f32x4 r0, r1; unpack8(*(const u32x4*)(b.RG() + ro + 128 * bj), r0, r1);
                        *(u32x4*)(b.Q() + ro + 128 * bj) = pack8(acc[ai][bj][m][0] * rs[ai][m] * g0 * r0, acc[ai][bj][m][1] * rs[ai][m] * g1 * r1); } }
            LDS_WAIT(); __builtin_amdgcn_s_barrier(); asm volatile("" ::: "memory");
        } break;
        case pg8::K_XS: if constexpr (PH == 22) {
            const int bh = u.pm(), bb = bh >> 2, h = bh & 3; const float C = 0.0625f * LOG2E;
            LAS f32x2* X = (LAS f32x2*)(lds + LDS_X);
            float ml[2][4];
#pragma unroll
            for (int ai = 0; ai < 2; ++ai)
#pragma unroll
                for (int m = 0; m < 4; ++m) { __builtin_amdgcn_sched_barrier(0); const int il = EROW(ai, m); float mx = -3.0e38f;
#pragma unroll
                    for (int bj = 0; bj < 2; ++bj)
#pragma unroll
                        for (int n = 0; n < 2; ++n) { const f32x4 v = acc[ai][bj][m][n] * C; acc[ai][bj][m][n] = v; mx = fmaxf(fmaxf(mx, fmaxf(v[0], v[1])), fmaxf(v[2], v[3])); }
                    mx = fmaxf(mx, __shfl_xor(mx, 16)); mx = fmaxf(mx, __shfl_xor(mx, 32)); float l = 0.f;
#pragma unroll
                    for (int bj = 0; bj < 2; ++bj)
#pragma unroll
                        for (int n = 0; n < 2; ++n) { f32x4 v = acc[ai][bj][m][n];
#pragma unroll
                            for (int e = 0; e < 4; ++e) { v[e] = __builtin_amdgcn_exp2f(v[e] - mx); l += v[e]; }
                            acc[ai][bj][m][n] = v; }
                    l += __shfl_xor(l, 16); l += __shfl_xor(l, 32); ml[ai][m] = mx;
                    if (fq == 0) X[il * 4 + wc] = (f32x2){mx, l}; }
            LDS_WAIT(); __builtin_amdgcn_s_barrier(); asm volatile("" ::: "memory");
#pragma unroll
            for (int ai = 0; ai < 2; ++ai)
#pragma unroll
                for (int m = 0; m < 4; ++m) { __builtin_amdgcn_sched_barrier(0); const int il = EROW(ai, m);
                    const f32x2 t0 = X[il * 4 + 0], t1 = X[il * 4 + 1], t2 = X[il * 4 + 2], t3 = X[il * 4 + 3];
                    const float M = fmaxf(fmaxf(t0.x, t1.x), fmaxf(t2.x, t3.x));
                    const float L = t0.y * __builtin_amdgcn_exp2f(t0.x - M) + t1.y * __builtin_amdgcn_exp2f(t1.x - M) + t2.y * __builtin_amdgcn_exp2f(t2.x - M) + t3.y * __builtin_amdgcn_exp2f(t3.x - M);
                    const float f = __builtin_amdgcn_exp2f(ml[ai][m] - M) * __builtin_amdgcn_rcpf(L);
                    bf16* rowp = b.MQ() + (size_t)(bb * SEQ + u.pn() * 256 + il) * D + h * 256 + cl;
#pragma unroll
                    for (int bj = 0; bj < 2; ++bj) *(u32x4*)(rowp + 128 * bj) = pack8(acc[ai][bj][m][0] * f, acc[ai][bj][m][1] * f); }
            LDS_WAIT(); __builtin_amdgcn_s_barrier(); asm volatile("" ::: "memory");
        } break;
        case pg8::K_XO: if constexpr (PH == 3) {
            const int bh = u.pm(), bb = bh >> 2, h = bh & 3;
#pragma unroll
            for (int ai = 0; ai < 2; ++ai)
#pragma unroll
                for (int m = 0; m < 4; ++m) { __builtin_amdgcn_sched_barrier(0); const size_t ro = (size_t)(bb * SEQ + u.pn() * 256 + EROW(ai, m)) * D + h * 256 + cl;
#pragma unroll
                    for (int bj = 0; bj < 2; ++bj) { f32x4 g0, g1; unpack8(*(const u32x4*)(b.MG() + ro + 128 * bj), g0, g1);
                        *(u32x4*)(b.MQ() + ro + 128 * bj) = pack8(acc[ai][bj][m][0] * g0, acc[ai][bj][m][1] * g1); } }
        } break;
        case pg8::K_P3A: if constexpr (PH == 4) {
            const int br = u.aux();
#pragma unroll
            for (int ai = 0; ai < 2; ++ai)
#pragma unroll
                for (int m = 0; m < 4; ++m) { __builtin_amdgcn_sched_barrier(0); const size_t ro = (size_t)(u.pm() * 256 + EROW(ai, m)) * D + u.pn() * 256 + cl;
#pragma unroll
                    for (int bj = 0; bj < 2; ++bj) { f32x4 g0, g1; unpack8(*(const u32x4*)(b.GATES() + (size_t)br * MT * D + ro + 128 * bj), g0, g1);
                        f32x4 v0 = acc[ai][bj][m][0] * g0, v1 = acc[ai][bj][m][1] * g1; float* mp = b.out + O_Y + ro + 128 * bj;
                        if (br > 0) { v0 += *(const f32x4*)mp; v1 += *(const f32x4*)(mp + 4); }
                        if (br < 2) { *(f32x4*)mp = v0; *(f32x4*)(mp + 4) = v1; } else *(u32x4*)(b.H() + ro + 128 * bj) = pack8(v0, v1); } }
        } break;
        case pg8::K_P3B: if constexpr (PH == 5) {
            float* rowss = (float*)(b.ctl() + CW_ROWSS);
#pragma unroll
            for (int ai = 0; ai < 2; ++ai)
#pragma unroll
                for (int m = 0; m < 4; ++m) { __builtin_amdgcn_sched_barrier(0); const int r = u.pm() * 256 + EROW(ai, m); const size_t ro = (size_t)r * D + u.pn() * 256 + cl;
                    const float* xr = (r < MP ? b.xp() + (size_t)r * D : b.xs() + (size_t)(r - MP) * D) + u.pn() * 256 + cl; float ss = 0.f;
#pragma unroll
                    for (int bj = 0; bj < 2; ++bj) { const f32x4 v0 = acc[ai][bj][m][0] + *(const f32x4*)(xr + 128 * bj), v1 = acc[ai][bj][m][1] + *(const f32x4*)(xr + 128 * bj + 4);
                        *(f32x4*)(b.out + O_Y + ro + 128 * bj) = v0; *(f32x4*)(b.out + O_Y + ro + 128 * bj + 4) = v1;
                        ss += (v0[0] * v0[0] + v0[1] * v0[1]) + (v0[2] * v0[2] + v0[3] * v0[3]) + (v1[0] * v1[0] + v1[1] * v1[1]) + (v1[2] * v1[2] + v1[3] * v1[3]); }
                    ss += __shfl_xor(ss, 16); ss += __shfl_xor(ss, 32);
                    if (fq == 0) atomicAdd(rowss + r, ss); }
        } break;
        default: break;
        }
    }
#undef EROW
};

#define XB_TMO      128
#define XB_XCNT(j)  (256  + 64 * (j))
#define XB_XSUB(j)  (1280 + 64 * (j))
#define XB_XGEN(j)  (2304 + 64 * (j))
#define XB_TOP      3328
#define XB_TOPGEN   3392
#define XCD_BAR_WORDS 3456
#define XB_SPIN_CAP (1u << 18)
__device__ __forceinline__ unsigned xb_ld(unsigned* p)              { return __hip_atomic_load(p, __ATOMIC_RELAXED, __HIP_MEMORY_SCOPE_AGENT); }
__device__ __forceinline__ unsigned xb_add(unsigned* p, unsigned v) { return __hip_atomic_fetch_add(p, v, __ATOMIC_RELAXED, __HIP_MEMORY_SCOPE_AGENT); }
__device__ __forceinline__ unsigned xb_xcc_id() { return (unsigned)__builtin_amdgcn_s_getreg((3 << 11) | 20) & 0xFu; }
#define XB_SPIN(cond, bar) do { unsigned _sp = 0; while (cond) { __builtin_amdgcn_s_sleep(1); \
    if ((++_sp & 255u) == 0u) { if (xb_ld(&(bar)[XB_TMO])) break; if (_sp > XB_SPIN_CAP) { atomicAdd(&(bar)[XB_TMO], 1u); break; } } } } while (0)
struct XcdBarrier { unsigned* bar; unsigned x; volatile LAS unsigned* st; };
__device__ __forceinline__ XcdBarrier xcd_barrier_post(unsigned* bar, volatile LAS unsigned* st) {
    XcdBarrier b; b.bar = bar; b.x = xb_xcc_id(); b.st = st;
    if (threadIdx.x == 0) (void)xb_add(&bar[XB_XCNT(b.x)], 1u);
    return b;
}
__device__ __forceinline__ void xcd_barrier_complete(unsigned* bar, unsigned x, unsigned& nloc, unsigned& nx) {
    const unsigned G = gridDim.x * gridDim.y * gridDim.z;
    unsigned sum, cnt, mine, sp = 0u;
    for (;;) {
        sum = 0u; cnt = 0u; mine = 0u;
#pragma unroll
        for (unsigned j = 0; j < 16; ++j) { const unsigned c = xb_ld(&bar[XB_XCNT(j)]); sum += c; cnt += (c > 0u) ? 1u : 0u; mine = (j == x) ? c : mine; }
        if (sum == G) break;
        __builtin_amdgcn_s_sleep(1);
        if ((++sp & 255u) == 0u) { if (xb_ld(&bar[XB_TMO])) break; if (sp > XB_SPIN_CAP) { atomicAdd(&bar[XB_TMO], 1u); break; } }
    }
    nloc = mine > 0u ? mine : 1u; nx = cnt > 0u ? cnt : 1u;
}
__device__ __forceinline__ void xcd_barrier(const XcdBarrier& b) {
    asm volatile("s_waitcnt vmcnt(0)" ::: "memory");
    __syncthreads();
    if (threadIdx.x == 0) {
        unsigned* bar = b.bar;
        __builtin_amdgcn_s_waitcnt(0);
        unsigned nloc = b.st[0], nx = b.st[1];
        if (nloc == 0u) { xcd_barrier_complete(bar, b.x, nloc, nx); b.st[0] = nloc; b.st[1] = nx; }
        const unsigned old = xb_add(&bar[XB_XSUB(b.x)], 1u);
        const unsigned gen = old / nloc;
        if (old + 1u == (gen + 1u) * nloc) {
            __builtin_amdgcn_fence(__ATOMIC_RELEASE, "agent");
            asm volatile("s_waitcnt vmcnt(0)" ::: "memory");
            const unsigned og = xb_add(&bar[XB_TOP], 1u);
            const unsigned tg = og / nx;
            if (og + 1u == (tg + 1u) * nx) xb_add(&bar[XB_TOPGEN], 1u);
            else XB_SPIN(xb_ld(&bar[XB_TOPGEN]) == tg, bar);
            __builtin_amdgcn_fence(__ATOMIC_ACQUIRE, "agent");
            xb_add(&bar[XB_XGEN(b.x)], 1u);
            asm volatile("s_waitcnt vmcnt(0)" ::: "memory");
        } else {
            XB_SPIN(xb_ld(&bar[XB_XGEN(b.x)]) == gen, bar);
            __builtin_amdgcn_fence(__ATOMIC_ACQUIRE, "agent");
            asm volatile("s_waitcnt vmcnt(0)" ::: "memory");
        }
    }
    __syncthreads();
}

__device__ __forceinline__ void p0_transpose_item(const float* W, int K, int N, bf16* WT, int src_col0, int dst_row0, int k0, LAS float* scr, int lane) {
#pragma unroll 8
    for (int i = 0; i < 32; ++i) { const int kk = 2 * i + (lane >> 5); scr[kk * 33 + (lane & 31)] = W[(size_t)(k0 + kk) * N + src_col0 + (lane & 31)]; }
    LDS_WAIT(); asm volatile("" ::: "memory");
    const int c = lane & 7;
#pragma unroll
    for (int j = 0; j < 4; ++j) { const int n = (lane >> 3) + 8 * j; const LAS float* s = scr + (8 * c) * 33 + n;
        u32x4 o; o.x = pk2(s[0 * 33], s[1 * 33]); o.y = pk2(s[2 * 33], s[3 * 33]); o.z = pk2(s[4 * 33], s[5 * 33]); o.w = pk2(s[6 * 33], s[7 * 33]);
        *(u32x4*)(WT + (size_t)(dst_row0 + n) * K + k0 + 8 * c) = o; }
    LDS_WAIT(); asm volatile("" ::: "memory");
}
__device__ __forceinline__ int win_src_col(int n) {
    const int tile = n >> 8, w = n & 255;
    if (tile >= 16 && tile < 24) { const int t = tile - 16; return w < 128 ? 4096 + 128 * t + w : 6144 + 128 * t + (w - 128); }
    if (tile >= 24 && tile < 32) { const int t = tile - 24; return w < 128 ? 5120 + 128 * t + w : 7168 + 128 * t + (w - 128); }
    return n;
}
__device__ __forceinline__ void rms_row_to_bf16(const float* xrow, const float* g, bf16* orow, int lane) {
    const f32x4* xr = (const f32x4*)xrow + lane; const f32x4* gr = (const f32x4*)g + lane;
    f32x4 v[4]; float s = 0.f;
#pragma unroll
    for (int j = 0; j < 4; ++j) { v[j] = xr[64 * j]; s += (v[j][0] * v[j][0] + v[j][1] * v[j][1]) + (v[j][2] * v[j][2] + v[j][3] * v[j][3]); }
    const float rstd = 1.0f / sqrtf(wave_sum(s) * (1.f / D) + EPS);
    u32x2* o8 = (u32x2*)orow + lane;
#pragma unroll
    for (int j = 0; j < 4; ++j) { const f32x4 gg = gr[64 * j]; const f32x4 y = v[j] * rstd * gg; u32x2 w; w.x = pk2(y[0], y[1]); w.y = pk2(y[2], y[3]); o8[64 * j] = w; }
}
__device__ __forceinline__ void sincos_d(double a, float& s, float& c) {
    const double TWO_OVER_PI = 0.63661977236758134308, PIO2_HI = 1.57079632679489655800e+00, PIO2_LO = 6.12323399573676603587e-17;
    const double q = rint(a * TWO_OVER_PI); double t = fma(-q, PIO2_HI, a); t = fma(-q, PIO2_LO, t);
    const double t2 = t * t;
    double sp = -1.0 / 1307674368000.0; sp = fma(sp, t2, 1.0 / 6227020800.0); sp = fma(sp, t2, -1.0 / 39916800.0); sp = fma(sp, t2, 1.0 / 362880.0); sp = fma(sp, t2, -1.0 / 5040.0); sp = fma(sp, t2, 1.0 / 120.0); sp = fma(sp, t2, -1.0 / 6.0); sp = fma(sp * t2, t, t);
    double cp = 1.0 / 20922789888000.0; cp = fma(cp, t2, -1.0 / 87178291200.0); cp = fma(cp, t2, 1.0 / 479001600.0); cp = fma(cp, t2, -1.0 / 3628800.0); cp = fma(cp, t2, 1.0 / 40320.0); cp = fma(cp, t2, -1.0 / 720.0); cp = fma(cp, t2, 1.0 / 24.0); cp = fma(cp, t2, -0.5); cp = fma(cp, t2, 1.0);
    const int qi = (int)((long long)q & 3);
    const double sr = (qi == 0) ? sp : (qi == 1) ? cp : (qi == 2) ? -sp : -cp;
    const double cr = (qi == 0) ? cp : (qi == 1) ? -sp : (qi == 2) ? -cp : sp;
    s = (float)sr; c = (float)cr;
}
__device__ __forceinline__ void p0_prologue(const Bufs& b, LAS unsigned char* lds, int vcu, int G, int wave, int lane, int tid) {
    LAS float* scr = (LAS float*)(lds + wave * 16384);
    const int gw = vcu * NWAVES + wave, NGW = G * NWAVES;
    constexpr int I_IN = 16 * (NIN / 32), I_SQ = 16 * 32, I_KV = 16 * 64, NITEMS = I_IN + 4 * I_SQ + I_KV;
    for (int it = gw; it < NITEMS; it += NGW) {
        int r = it;
        if (r < I_IN) { const int nb = r >> 4, kb = r & 15; p0_transpose_item(b.w_in(), D, NIN, b.Win(), win_src_col(nb * 32), nb * 32, kb * 64, scr, lane); continue; } r -= I_IN;
        if (r < 4 * I_SQ) { const int wsel = r / I_SQ, q = r % I_SQ, nb = q >> 4, kb = q & 15;
            const float* W = wsel == 0 ? b.w_ro() : wsel == 1 ? b.w_co() : wsel == 2 ? b.w_mo() : b.w_out(); bf16* WT = wsel == 0 ? b.Wro() : wsel == 1 ? b.Wco() : wsel == 2 ? b.Wmo() : b.Wout();
            p0_transpose_item(W, D, D, WT, nb * 32, nb * 32, kb * 64, scr, lane); continue; } r -= 4 * I_SQ;
        { const int nb = r >> 4, kb = r & 15; p0_transpose_item(b.w_mkv(), D, 2 * D, b.Wmkv(), nb * 32, nb * 32, kb * 64, scr, lane); }
    }
    for (int m = gw; m < MT; m += NGW) rms_row_to_bf16(m < MP ? b.xp() + (size_t)m * D : b.xs() + (size_t)(m - MP) * D, b.norm_g(), b.H() + (size_t)m * D, lane);
    for (int m = gw; m < NB * 256; m += NGW) rms_row_to_bf16(b.memp() + (size_t)m * D, b.memn_g(), b.MN() + (size_t)m * D, lane);
    for (int e = vcu * 512 + tid; e < NPOS * 128; e += G * 512) {
        const int p = e >> 7, j = e & 127; const double pos = p < SEQ ? (double)p : (double)(16384 + (p - SEQ));
        double inv = 1.0, bs = 0.93057204092969897916;
#pragma unroll
        for (int k = 0; k < 7; ++k) { if ((j >> k) & 1) inv *= bs; bs *= bs; }
        float s, c; sincos_d(pos * inv, s, c); b.cosT()[e] = c; b.sinT()[e] = s;
    }
}

__device__ __forceinline__ void ret_sample_unit(const Bufs& b, LAS unsigned char* lds, int bb, int h, int tid, int wave, int lane) {
    LAS float* qk = (LAS float*)lds;
    LAS float* red = (LAS float*)(lds + 16384);
    LAS float* Ap = (LAS float*)(lds + 16384 + 65536);
    const float ch = b.clg(h);
    const int r0 = MP + bb * DECS;
    {
        const int row = tid & 15, dch = tid >> 4; const bf16* src = (row < 8 ? b.Q() : b.KT()) + (size_t)(r0 + (row & 7)) * D + h * 256 + dch * 8;
        f32x4 a0, a1; unpack8(*(const u32x4*)src, a0, a1); float sc = 1.f;
        if (row >= 8) sc = __builtin_amdgcn_exp2f(-(float)(7 - (row & 7)) * ch);
#pragma unroll
        for (int e = 0; e < 4; ++e) { qk[(dch * 8 + e) * 16 + row] = a0[e] * sc; qk[(dch * 8 + 4 + e) * 16 + row] = a1[e] * sc; }
    }
    f32x4 vv[8];
#pragma unroll
    for (int j = 0; j < 8; ++j) { const u32x2 w = *(const u32x2*)(b.Vs() + (size_t)(bb * DECS + j) * D + h * 256 + 4 * lane); vv[j] = (f32x4){bflo(w.x), bfhi(w.x), bflo(w.y), bfhi(w.y)}; }
    LDS_WAIT(); __syncthreads();
    f32x4 oacc[8];
#pragma unroll
    for (int i = 0; i < 8; ++i) oacc[i] = (f32x4){0.f, 0.f, 0.f, 0.f};
    const size_t sbase = (size_t)(bb * 4 + h) * 65536;
    const float* sin_ = b.state_ret() + sbase + 4 * lane; float* sout = b.out + O_RS + sbase + 4 * lane; const float g8 = __builtin_amdgcn_exp2f(-8.0f * ch);
#pragma unroll 1
    for (int d0 = wave * 32; d0 < wave * 32 + 32; d0 += 8) {
        f32x4 s0[8];
#pragma unroll
        for (int k = 0; k < 8; ++k) s0[k] = *(const f32x4*)(sin_ + (size_t)(d0 + k) * 256);
#pragma unroll
        for (int k = 0; k < 8; ++k) {
            const LAS f32x4* qr = (const LAS f32x4*)(qk + (d0 + k) * 16); const f32x4 q0 = qr[0], q1 = qr[1], k0 = qr[2], k1 = qr[3];
            f32x4 sn = s0[k] * g8;
#pragma unroll
            for (int i = 0; i < 4; ++i) { oacc[i] += s0[k] * q0[i]; oacc[4 + i] += s0[k] * q1[i]; sn += vv[i] * k0[i]; sn += vv[4 + i] * k1[i]; }
            *(f32x4*)(sout + (size_t)(d0 + k) * 256) = sn;
        }
    }
#pragma unroll
    for (int i = 0; i < 8; ++i) *(LAS f32x4*)(red + (wave * 8 + i) * 256 + 4 * lane) = oacc[i];
    {
        const int i = lane >> 3, j = lane & 7; float s = 0.f;
#pragma unroll 8
        for (int d = wave * 32; d < wave * 32 + 32; ++d) s += qk[d * 16 + i] * qk[d * 16 + 8 + j];
        Ap[wave * 64 + lane] = s;
    }
    LDS_WAIT(); __syncthreads();
    {
        const int i = wave; f32x4 o = (f32x4){0.f, 0.f, 0.f, 0.f};
#pragma unroll
        for (int w = 0; w < 8; ++w) o += *(const LAS f32x4*)(red + (w * 8 + i) * 256 + 4 * lane);
        o *= __builtin_amdgcn_exp2f(-(float)(i + 1) * ch);
        const float gi7 = __builtin_amdgcn_exp2f((float)(7 - i) * ch);
#pragma unroll
        for (int j = 0; j < 8; ++j) { if (j <= i) { float a = 0.f;
#pragma unroll
                for (int w = 0; w < 8; ++w) a += Ap[w * 64 + i * 8 + j];
                o += vv[j] * (a * gi7); } }
        const float ss = wave_sum((o[0] * o[0] + o[1] * o[1]) + (o[2] * o[2] + o[3] * o[3]));
        const float rstd = 1.0f / sqrtf(ss * (1.0f / 256.0f) + EPS);
        const f32x4 g = *(const f32x4*)(b.ret_g() + h * 256 + 4 * lane);
        const size_t ro = (size_t)(r0 + i) * D + h * 256 + 4 * lane;
        const u32x2 rw = *(const u32x2*)(b.RG() + ro); const f32x4 rg = (f32x4){bflo(rw.x), bfhi(rw.x), bflo(rw.y), bfhi(rw.y)};
        const f32x4 y = o * rstd * g * rg; u32x2 w; w.x = pk2(y[0], y[1]); w.y = pk2(y[2], y[3]);
        *(u32x2*)(b.Q() + ro) = w;
    }
    LDS_WAIT(); __syncthreads();
}
__device__ __forceinline__ void xattn_sample_unit(const Bufs& b, LAS unsigned char* lds, int bb, int h, int tid, int wave, int lane) {
    LAS float* sc = (LAS float*)lds;
    LAS float* pT = (LAS float*)(lds + 8192);
    LAS float* red = (LAS float*)(lds + 16384);
    const int r0 = MP + bb * DECS; const int fr = lane & 15, fq = lane >> 4;
    bf16x8 bq[8];
#pragma unroll
    for (int kk = 0; kk < 8; ++kk) { u32x4 w = (u32x4){0u, 0u, 0u, 0u}; if (fr < 8) w = *(const u32x4*)(b.MQ() + (size_t)(r0 + fr) * D + h * 256 + 32 * kk + 8 * fq); bq[kk] = __builtin_bit_cast(bf16x8, w); }
#pragma unroll
    for (int g = 0; g < 2; ++g) {
        const int key0 = (wave * 2 + g) * 16; const float* kp = b.cmk() + ((size_t)(bb * 256 + key0 + fr) * 4 + h) * 256 + 8 * fq;
        f32x4 ka[8][2];
#pragma unroll
        for (int kk = 0; kk < 8; ++kk) { ka[kk][0] = *(const f32x4*)(kp + 32 * kk); ka[kk][1] = *(const f32x4*)(kp + 32 * kk + 4); }
        f32x4 a4 = (f32x4){0.f, 0.f, 0.f, 0.f};
#pragma unroll
        for (int kk = 0; kk < 8; ++kk) { const u32x4 w = pack8(ka[kk][0], ka[kk][1]); a4 = __builtin_amdgcn_mfma_f32_16x16x32_bf16(__builtin_bit_cast(bf16x8, w), bq[kk], a4, 0, 0, 0); }
        if (fr < 8) {
#pragma unroll
            for (int r = 0; r < 4; ++r) sc[fr * 256 + key0 + 4 * fq + r] = a4[r] * (0.0625f * LOG2E);
        }
    }
    LDS_WAIT(); __syncthreads();
    {
        const int i = wave; const f32x4 s = *(const LAS f32x4*)(sc + i * 256 + 4 * lane);
        const float mx = wave_max(fmaxf(fmaxf(s[0], s[1]), fmaxf(s[2], s[3])));
        f32x4 e; float l = 0.f;
#pragma unroll
        for (int r = 0; r < 4; ++r) { e[r] = __builtin_amdgcn_exp2f(s[r] - mx); l += e[r]; }
        const float inv = 1.0f / wave_sum(l);
#pragma unroll
        for (int r = 0; r < 4; ++r) pT[(4 * lane + r) * 8 + i] = e[r] * inv;
    }
    LDS_WAIT(); __syncthreads();
    f32x4 oacc[8];
#pragma unroll
    for (int i = 0; i < 8; ++i) oacc[i] = (f32x4){0.f, 0.f, 0.f, 0.f};
    const float* vp = b.cmv() + ((size_t)(bb * 256) * 4 + h) * 256 + 4 * lane;
#pragma unroll 1
    for (int m0 = wave * 32; m0 < wave * 32 + 32; m0 += 8) {
        f32x4 v[8];
#pragma unroll
        for (int k = 0; k < 8; ++k) v[k] = *(const f32x4*)(vp + (size_t)(m0 + k) * 1024);
#pragma unroll
        for (int k = 0; k < 8; ++k) { const LAS f32x4* pr = (const LAS f32x4*)(pT + (m0 + k) * 8); const f32x4 p0 = pr[0], p1 = pr[1];
#pragma unroll
            for (int i = 0; i < 4; ++i) { oacc[i] += v[k] * p0[i]; oacc[4 + i] += v[k] * p1[i]; } }
    }
#pragma unroll
    for (int i = 0; i < 8; ++i) *(LAS f32x4*)(red + (wave * 8 + i) * 256 + 4 * lane) = oacc[i];
    LDS_WAIT(); __syncthreads();
    {
        const int i = wave; f32x4 o = (f32x4){0.f, 0.f, 0.f, 0.f};
#pragma unroll
        for (int w = 0; w < 8; ++w) o += *(const LAS f32x4*)(red + (w * 8 + i) * 256 + 4 * lane);
        const size_t ro = (size_t)(r0 + i) * D + h * 256 + 4 * lane;
        const u32x2 gw = *(const u32x2*)(b.MG() + ro); const f32x4 y = o * (f32x4){bflo(gw.x), bfhi(gw.x), bflo(gw.y), bfhi(gw.y)};
        u32x2 w; w.x = pk2(y[0], y[1]); w.y = pk2(y[2], y[3]);
        LDS_WAIT(); __syncthreads();
        *(u32x2*)(b.MQ() + ro) = w;
    }
}
__device__ __forceinline__ void conv_chunk(const Bufs& b, int chunk, int tid) {
    const int task = chunk * 512 + tid; constexpr int NPT = (MP / 16) * 128;
    int r0, nrows, t0; const float* st = nullptr;
    const int cg = task & 127, c0 = cg * 8;
    if (task < NPT) { const int run = task >> 7; r0 = run * 16; nrows = 16; t0 = r0 & (SEQ - 1); }
    else { const int run = (task - NPT) >> 7; r0 = MP + run * 8; nrows = 8; t0 = 0; st = b.state_conv() + (size_t)run * 2 * D + c0; }
    f32x4 w0a = *(const f32x4*)(b.conv_w() + c0), w0b = *(const f32x4*)(b.conv_w() + c0 + 4), w1a = *(const f32x4*)(b.conv_w() + D + c0), w1b = *(const f32x4*)(b.conv_w() + D + c0 + 4),
          w2a = *(const f32x4*)(b.conv_w() + 2 * D + c0), w2b = *(const f32x4*)(b.conv_w() + 2 * D + c0 + 4), ba = *(const f32x4*)(b.conv_b() + c0), bb_ = *(const f32x4*)(b.conv_b() + c0 + 4);
    f32x4 xm2a, xm2b, xm1a, xm1b;
    const f32x4 z = (f32x4){0.f, 0.f, 0.f, 0.f};
    if (t0 >= 2) { unpack8(*(const u32x4*)(b.PRE() + (size_t)(r0 - 2) * D + c0), xm2a, xm2b); unpack8(*(const u32x4*)(b.PRE() + (size_t)(r0 - 1) * D + c0), xm1a, xm1b); }
    else if (st) { xm2a = *(const f32x4*)st; xm2b = *(const f32x4*)(st + 4); xm1a = *(const f32x4*)(st + D); xm1b = *(const f32x4*)(st + D + 4); }
    else { xm2a = z; xm2b = z; xm1a = z; xm1b = z; }
#pragma unroll 4
    for (int k = 0; k < nrows; ++k) {
        const size_t ro = (size_t)(r0 + k) * D + c0;
        f32x4 xa, xb, ga, gb; unpack8(*(const u32x4*)(b.PRE() + ro), xa, xb); unpack8(*(const u32x4*)(b.GCB() + ro), ga, gb);
        const f32x4 ya = ga * (ba + w0a * xm2a + w1a * xm1a + w2a * xa), yb = gb * (bb_ + w0b * xm2b + w1b * xm1b + w2b * xb);
        *(u32x4*)(b.GCB() + ro) = pack8(ya, yb);
        xm2a = xm1a; xm2b = xm1b; xm1a = xa; xm1b = xb;
    }
}
constexpr int NSTREAM_RET = DECB * 4, NSTREAM_X = DECB * 4, NSTREAM_CONV = ((MP / 16) * 128 + DECB * 128) / 512;

__global__ void __launch_bounds__(NWAVES * 64, 2) fwd_kernel(Params p) {
    extern __shared__ __attribute__((aligned(16))) unsigned char lds_[];
    LAS unsigned char* lds = (LAS unsigned char*)lds_;
    volatile LAS unsigned* MISC = (volatile LAS unsigned*)(lds + LDS_MISC);
    const int tid = threadIdx.x, lane = tid & 63, wave = __builtin_amdgcn_readfirstlane(tid >> 6);
    const int G = gridDim.x, bx = blockIdx.x, vcu = (G % 8 == 0) ? (bx % 8) * (G / 8) + bx / 8 : bx;
    Bufs b; b.ka = (kargp_t)__builtin_amdgcn_kernarg_segment_ptr(); b.ws = p.ws; b.out = p.out;
    if (tid < 64) MISC[tid] = 0u;
    __syncthreads();
    XcdBarrier bar = xcd_barrier_post(b.ctl() + CW_BAR, MISC + 8);

    const int lo = p.ph_lo, hi = p.ph_hi;
#ifndef PHMASK
#define PHMASK 0x7f
#endif
#define IN(k) (((PHMASK >> (k)) & 1) && lo <= (k) && (k) < hi)
#define SEAM(k) do { if (IN(k) && IN((k) + 1)) xcd_barrier(bar); } while (0)
#define GEMM_PHASE(k) do { Sched<k> S; S.G = G; S.c = bx; S.b = b; Epi<k> E; E.bufs = b; pg8::gemm_phase<Sched<k>, Epi<k>>(lds, S, E); } while (0)
    if (IN(0)) p0_prologue(b, lds, vcu, G, wave, lane, tid);
    SEAM(0);
    if (IN(1)) GEMM_PHASE(1);
    SEAM(1);
    if (IN(2)) {
#ifndef NO_G2
        GEMM_PHASE(20); GEMM_PHASE(21); GEMM_PHASE(22);
#endif
#ifndef NO_STREAM
        unsigned* qh = b.ctl() + CW_QUEUE;
        for (;;) {
            __syncthreads();
            if (tid == 0) MISC[0] = __hip_atomic_fetch_add(qh, 1u, __ATOMIC_RELAXED, __HIP_MEMORY_SCOPE_AGENT);
            __syncthreads();
            const int item = (int)MISC[0];
            if (item >= NSTREAM_RET + NSTREAM_X + NSTREAM_CONV) break;
            if (item < NSTREAM_RET) ret_sample_unit(b, lds, item >> 2, item & 3, tid, wave, lane);
            else if (item < NSTREAM_RET + NSTREAM_X) xattn_sample_unit(b, lds, (item - NSTREAM_RET) >> 2, (item - NSTREAM_RET) & 3, tid, wave, lane);
            else conv_chunk(b, item - NSTREAM_RET - NSTREAM_X, tid);
        }
#endif
    }
    SEAM(2);
    if (IN(3)) GEMM_PHASE(3);
    SEAM(3);
    if (IN(4)) GEMM_PHASE(4);
    SEAM(4);
    if (IN(5)) GEMM_PHASE(5);
    SEAM(5);
    if (IN(6)) {
        const float* rowss = (const float*)(b.ctl() + CW_ROWSS);
        for (int m = vcu * NWAVES + wave; m < MT; m += G * NWAVES) {
            f32x4* yr = (f32x4*)(b.out + O_Y + (size_t)m * D) + lane; const f32x4* gr = (const f32x4*)b.fin_g() + lane;
            const float rstd = 1.0f / sqrtf(__hip_atomic_load(rowss + m, __ATOMIC_RELAXED, __HIP_MEMORY_SCOPE_AGENT) * (1.f / D) + EPS);
#pragma unroll
            for (int j = 0; j < 4; ++j) yr[64 * j] = yr[64 * j] * rstd * gr[64 * j];
        }
    }
#undef IN
#undef SEAM
#undef GEMM_PHASE
}

#ifndef MK_N_LAUNCHES
#define MK_N_LAUNCHES 7
#endif
extern "C" void kernel_launch(void* const* d_in, const int* in_sizes, int n_in, void* d_out, int out_size, void* d_ws, size_t ws_size, hipStream_t stream) {
    static int grid = 0;
    if (grid == 0) {
        if (n_in != 20 || (size_t)out_size != O_END || ws_size < WS_END) { fprintf(stderr, "kernel_launch: unexpected shapes (n_in %d, out %d, ws %zu); nothing launched\n", n_in, out_size, ws_size); grid = -1; return; }
        int dev = 0, cus = 0, per_cu = 0;
        if (hipGetDevice(&dev) != hipSuccess || hipDeviceGetAttribute(&cus, hipDeviceAttributeMultiprocessorCount, dev) != hipSuccess) { grid = -1; return; }
        if (hipFuncSetAttribute((const void*)fwd_kernel, hipFuncAttributeMaxDynamicSharedMemorySize, LDS_BYTES) != hipSuccess) { fprintf(stderr, "kernel_launch: hipFuncSetAttribute failed\n"); grid = -1; return; }
        if (hipOccupancyMaxActiveBlocksPerMultiprocessor(&per_cu, (const void*)fwd_kernel, NWAVES * 64, LDS_BYTES) != hipSuccess || per_cu < 1) { fprintf(stderr, "kernel_launch: occupancy query says %d blocks per CU\n", per_cu); (void)hipGetLastError(); grid = -1; return; }
        grid = cus;
        if (grid > 256 || grid < 64) { fprintf(stderr, "kernel_launch: %d CUs unsupported\n", grid); grid = -1; return; }
    }
    if (grid < 0) return;
    (void)hipMemsetAsync((char*)d_ws + WS_CTL, 0, CTL_ZERO_BYTES, stream);
    Params p{};
    for (int i = 0; i < 20; ++i) p.in[i] = (const float*)d_in[i];
    p.out = (float*)d_out; p.ws = (unsigned char*)d_ws;
    for (int h = 0; h < 4; ++h) { const double g = 1.0 - std::exp2(-5.0 - (double)h); p.clog[h] = (float)(-std::log2(g)); }
    if (MK_N_LAUNCHES == 1) { p.ph_lo = 0; p.ph_hi = 7; hipLaunchKernelGGL(fwd_kernel, dim3(grid), dim3(NWAVES * 64), LDS_BYTES, stream, p); }
    else for (int ph = 0; ph < 7; ++ph) { p.ph_lo = ph; p.ph_hi = ph + 1; hipLaunchKernelGGL(fwd_kernel, dim3(grid), dim3(NWAVES * 64), LDS_BYTES, stream, p); }
}
```

```cpp
#include <hip/hip_runtime.h>
#include <cstdio>
#include <cstdint>
#include <cmath>
#include <cstddef>

#define LAS __attribute__((address_space(3)))
#define GAS __attribute__((address_space(1)))
typedef unsigned short bf16;
typedef short bf16x8 __attribute__((ext_vector_type(8)));
typedef float f32x4 __attribute__((ext_vector_type(4)));
typedef float f32x2 __attribute__((ext_vector_type(2)));
typedef unsigned u32x4 __attribute__((ext_vector_type(4)));
typedef unsigned u32x2 __attribute__((ext_vector_type(2)));
typedef __bf16 bf16x2_t __attribute__((ext_vector_type(2)));

constexpr int D = 1024, SEQ = 2048, NB = 8, DECB = 128, DECS = 8;
constexpr int MP = NB * SEQ;
constexpr int MS = DECB * DECS;
constexpr int MT = MP + MS;
constexpr int NIN = 13 * 1024;
constexpr int NPOS = SEQ + DECS;
constexpr float EPS = 1e-6f;
constexpr float LOG2E = 1.4426950408889634f;

constexpr size_t O_Y = 0, O_RP = (size_t)MT * D, O_RS = O_RP + (size_t)NB * 4 * 65536, O_CP = O_RS + (size_t)DECB * 4 * 65536,
                 O_CS = O_CP + (size_t)NB * 2 * D, O_MK = O_CS + (size_t)DECB * 2 * D, O_MV = O_MK + (size_t)NB * 256 * D, O_END = O_MV + (size_t)NB * 256 * D;

constexpr size_t MiB = 1u << 20;
constexpr size_t WS_CTL = 0, CTL_ZERO_BYTES = 1 * MiB;
constexpr size_t WS_COS = 1 * MiB, WS_SIN = 2 * MiB + 512 * 1024;
constexpr size_t WS_WRO = 4 * MiB, WS_WCO = 6 * MiB, WS_WMO = 8 * MiB, WS_WOUT = 10 * MiB, WS_WMKV = 12 * MiB, WS_WIN = 16 * MiB;
constexpr size_t WS_MN = 42 * MiB, WS_MKB = 46 * MiB, WS_MVT = 50 * MiB;
constexpr size_t WS_H = 54 * MiB;
constexpr size_t WS_Q = 88 * MiB;
constexpr size_t WS_KT = 122 * MiB;
constexpr size_t WS_KTT = 156 * MiB;
constexpr size_t WS_VT = 190 * MiB;
constexpr size_t WS_VS = 222 * MiB;
constexpr size_t WS_RG = 224 * MiB;
constexpr size_t WS_PRE = 258 * MiB;
constexpr size_t WS_GCB = 292 * MiB;
constexpr size_t WS_MQ = 326 * MiB;
constexpr size_t WS_MG = 360 * MiB;
constexpr size_t WS_GATES = 394 * MiB;
constexpr size_t WS_SALL = 496 * MiB;
constexpr size_t WS_GS = 528 * MiB;
constexpr size_t WS_END = 534 * MiB;

constexpr int CW_READY = 64;
constexpr int CW_BAR = 4096;
constexpr int CW_QUEUE = 8192;
constexpr int CW_MKDONE = 8192 + 128;
constexpr int CW_SREADY = 8192 + 192;
constexpr int CW_PCNT = 8192 + 256;
constexpr int CW_TCNT = 8192 + 1472;
constexpr int CW_SCNT = 8192 + 1408;
constexpr int CW_PART = 16384;

constexpr int LDS_BYTES = 163840, LDS_X = 131072, LDS_MISC = LDS_BYTES - 256;
constexpr int NWAVES = 8;
#ifndef PROBE_PHASE
#define PROBE_PHASE -1
#endif

__device__ __forceinline__ unsigned pk2(float lo, float hi) { f32x2 v = {lo, hi}; bf16x2_t b = __builtin_convertvector(v, bf16x2_t); return __builtin_bit_cast(unsigned, b); }
__device__ __forceinline__ float bflo(unsigned w) { return __uint_as_float(w << 16); }
__device__ __forceinline__ float bfhi(unsigned w) { return __uint_as_float(w & 0xffff0000u); }
__device__ __forceinline__ u32x4 pack8(f32x4 a, f32x4 b) { u32x4 w; w.x = pk2(a[0], a[1]); w.y = pk2(a[2], a[3]); w.z = pk2(b[0], b[1]); w.w = pk2(b[2], b[3]); return w; }
__device__ __forceinline__ void unpack8(u32x4 w, f32x4& a, f32x4& b) { a = (f32x4){bflo(w.x), bfhi(w.x), bflo(w.y), bfhi(w.y)}; b = (f32x4){bflo(w.z), bfhi(w.z), bflo(w.w), bfhi(w.w)}; }
__device__ __forceinline__ float sigm(float x) { return __builtin_amdgcn_rcpf(1.0f + __builtin_amdgcn_exp2f(-LOG2E * x)); }
__device__ __forceinline__ f32x4 sigm4(f32x4 x) { return (f32x4){sigm(x[0]), sigm(x[1]), sigm(x[2]), sigm(x[3])}; }
__device__ __forceinline__ f32x4 silu4(f32x4 x) { return x * sigm4(x); }
__device__ __forceinline__ float wave_sum(float v) {
#pragma unroll
    for (int o = 1; o < 64; o <<= 1) v += __shfl_xor(v, o);
    return v;
}
__device__ __forceinline__ float wave_max(float v) {
#pragma unroll
    for (int o = 1; o < 64; o <<= 1) v = fmaxf(v, __shfl_xor(v, o));
    return v;
}
#define LDS_WAIT() asm volatile("s_waitcnt lgkmcnt(0)" ::: "memory")
#define VM_WAIT() asm volatile("s_waitcnt vmcnt(0)" ::: "memory")

struct Params {
    const float* in[20]; float* out; unsigned char* ws;
    float clog[4];
    int ph_lo, ph_hi;
    int pad0, pad1;
};
static_assert(sizeof(Params) == 208 && offsetof(Params, clog) == 176, "Params layout (the kernel reads it through the kernarg segment pointer)");
typedef const __attribute__((address_space(4))) unsigned long long* kargp_t;
struct Bufs {
    kargp_t ka; unsigned char* ws; float* out;
    __device__ __forceinline__ const float* in(int i) const { return (const float*)ka[i]; }
    __device__ __forceinline__ float clg(int h) const { return __builtin_bit_cast(f32x2, ka[22 + (h >> 1)])[h & 1]; }
#define BUF_IN(name, i) __device__ __forceinline__ const float* name() const { return in(i); }
    BUF_IN(xp, 0) BUF_IN(xs, 1) BUF_IN(state_ret, 2) BUF_IN(state_conv, 3) BUF_IN(cmk, 4) BUF_IN(cmv, 5) BUF_IN(memp, 6) BUF_IN(norm_g, 7) BUF_IN(w_in, 8) BUF_IN(b_gate, 9)
    BUF_IN(ret_g, 10) BUF_IN(conv_w, 11) BUF_IN(conv_b, 12) BUF_IN(w_ro, 13) BUF_IN(w_co, 14) BUF_IN(w_mo, 15) BUF_IN(w_out, 16) BUF_IN(memn_g, 17) BUF_IN(w_mkv, 18) BUF_IN(fin_g, 19)
#undef BUF_IN
#define BUF_WS(T, name, off) __device__ __forceinline__ T* name() const { return (T*)(ws + (off)); }
    BUF_WS(unsigned, ctl, WS_CTL) BUF_WS(float, cosT, WS_COS) BUF_WS(float, sinT, WS_SIN)
    BUF_WS(bf16, Wro, WS_WRO) BUF_WS(bf16, Wco, WS_WCO) BUF_WS(bf16, Wmo, WS_WMO) BUF_WS(bf16, Wout, WS_WOUT) BUF_WS(bf16, Wmkv, WS_WMKV) BUF_WS(bf16, Win, WS_WIN)
    BUF_WS(bf16, MN, WS_MN) BUF_WS(bf16, MKb, WS_MKB) BUF_WS(bf16, MVt, WS_MVT) BUF_WS(bf16, H, WS_H) BUF_WS(bf16, Q, WS_Q) BUF_WS(bf16, KT, WS_KT) BUF_WS(bf16, KTt, WS_KTT)
    BUF_WS(bf16, Vt, WS_VT) BUF_WS(bf16, Vs, WS_VS) BUF_WS(bf16, RG, WS_RG) BUF_WS(bf16, PRE, WS_PRE) BUF_WS(bf16, GCB, WS_GCB) BUF_WS(bf16, MQ, WS_MQ) BUF_WS(bf16, MG, WS_MG)
    BUF_WS(bf16, GATES, WS_GATES) BUF_WS(bf16, SALL, WS_SALL) BUF_WS(bf16, GS, WS_GS) BUF_WS(float, YS, WS_Q)
    __device__ __forceinline__ bf16* smerged(int pn) const { return (bf16*)(ws + (pn == 0 ? WS_H + (size_t)MP * D * 2 : pn == 1 ? WS_KT + (size_t)MP * D * 2 : pn == 2 ? WS_PRE + (size_t)MP * D * 2 : WS_VS)); }
#undef BUF_WS
};

namespace pg8 {
constexpr int BM = 256, BK = 64, HALF = 128, HTB = HALF * BK * 2, STAGE_BYTES = 8 * HTB;
__host__ __device__ __forceinline__ int lds_byte(int r, int c) { const int st = (r >> 4) * 2 + (c >> 5), rr = r & 15, cc = c & 31, ob = rr * 64 + cc * 2; return st * 1024 + (ob ^ (((ob >> 9) & 1) << 5)); }
__host__ __device__ __forceinline__ void stage_rc(int b, int& R, int& C) { const int st = b / 1024, sb = b % 1024, swz = sb ^ (((sb >> 9) & 1) << 5); R = (st >> 1) * 16 + swz / 64; C = (st & 1) * 32 + (swz % 64) / 2; }
__host__ __device__ __forceinline__ int perm32(int rho) { const int n = rho >> 4, i = rho & 15; return 8 * (i >> 2) + 4 * n + (i & 3); }

enum Kind { K_RQ = 0, K_RK, K_RV, K_RVT, K_RG, K_CA, K_CB, K_MQ, K_MG, K_GL, K_MK, K_MVT, K_QK, K_CHAIN, K_XS, K_RETO, K_XO, K_P3A, K_P3B, K_P3S };
struct Unit {
    const char* A; const char* B;
    unsigned lda, ldb;
    unsigned meta;
    unsigned pmn;
    __device__ __forceinline__ int kind() const { return (int)(meta & 31u); }
    __device__ __forceinline__ int aux() const { return (int)((meta >> 6) & 3u); }
    __device__ __forceinline__ int nt() const { return (int)((meta >> 8) & 255u); }
    __device__ __forceinline__ bool keep() const { return (meta & 32u) != 0u; }
    __device__ __forceinline__ int pm() const { return (int)(pmn & 0xffffu); }
    __device__ __forceinline__ int pn() const { return (int)(pmn >> 16); }
    __device__ __forceinline__ void set(int kind, int pm, int pn, int nt = 16, int aux = 0, int keep = 0) { meta = (unsigned)kind | ((unsigned)keep << 5) | ((unsigned)aux << 6) | ((unsigned)nt << 8); pmn = (unsigned)pm | ((unsigned)pn << 16); }
};

template <class Sched, class Epi>
__device__ __forceinline__ void gemm_phase(LAS unsigned char* lds, const Sched& S, const Epi& E, int wid) {
    int lane = (int)__builtin_amdgcn_mbcnt_hi(~0u, __builtin_amdgcn_mbcnt_lo(~0u, 0u)); asm volatile("" : "+v"(lane));
    const int tid = wid * 64 + lane, wr = wid >> 2, wc = wid & 3, fr = lane & 15, fq = lane >> 4;
    unsigned Ra0, Rb0, Cc0;
    { int R, C; stage_rc(tid * 16, R, C); Ra0 = (unsigned)R; Rb0 = (unsigned)((R & ~31) + perm32(R & 31)); Cc0 = (unsigned)C * 2u; }
    const unsigned ldsw = (unsigned)wid * 1024u;
    const int aoff = lds_byte(wr * 64 + fr, fq * 8), boff = lds_byte(wc * 32 + fr, fq * 8);
#define PG8_SA(b, h) (((b) * 2 + (h)) * HTB)
#define PG8_SB(b, h) ((4 + (b) * 2 + (h)) * HTB)
#define PG8_STAGE(bufoff, gbase, R0, ld) do { const unsigned _v = (R0) * (ld) + Cc0; const char* _g = (const char*)(gbase); \
        __builtin_amdgcn_global_load_lds((const unsigned*)(_g + _v), (LAS unsigned*)(lds + (bufoff) + ldsw), 16, 0, 0); \
        __builtin_amdgcn_global_load_lds((const unsigned*)(_g + 64u * (ld) + _v), (LAS unsigned*)(lds + (bufoff) + ldsw + 8192), 16, 0, 0); } while (0)
#define PG8_STA(bufoff, gbase, ld) PG8_STAGE(bufoff, gbase, Ra0, ld)
#define PG8_STB(bufoff, gbase, ld) PG8_STAGE(bufoff, gbase, Rb0, ld)
#define PG8_LDA(dst, b, h) do { _Pragma("unroll") for (int m = 0; m < 4; ++m) _Pragma("unroll") for (int k = 0; k < 2; ++k) dst[m][k] = *(const LAS bf16x8*)(lds + PG8_SA(b, h) + aoff + m * 2048 + k * 1024); } while (0)
#define PG8_LDB(dst, b, h) do { _Pragma("unroll") for (int n = 0; n < 2; ++n) _Pragma("unroll") for (int k = 0; k < 2; ++k) dst[n][k] = *(const LAS bf16x8*)(lds + PG8_SB(b, h) + boff + n * 2048 + k * 1024); } while (0)
#define PG8_MMA(ai, bj, At, Bt) do { __builtin_amdgcn_s_setprio(1); _Pragma("unroll") for (int m = 0; m < 4; ++m) _Pragma("unroll") for (int n = 0; n < 2; ++n) _Pragma("unroll") for (int k = 0; k < 2; ++k) \
        acc[ai][bj][m][n] = __builtin_amdgcn_mfma_f32_16x16x32_bf16(Bt[n][k], At[m][k], acc[ai][bj][m][n], 0, 0, 0); __builtin_amdgcn_s_setprio(0); } while (0)
#define PG8_WAIT_V(n) asm volatile("s_waitcnt vmcnt(" #n ")" ::: "memory")
#define PG8_WAIT_L(n) asm volatile("s_waitcnt lgkmcnt(" #n ")" ::: "memory")
#define PG8_BAR __builtin_amdgcn_s_barrier()
#define PG8_SCHED __builtin_amdgcn_sched_barrier(0)
#define PG8_PA(u, tt) ((u).A + (unsigned)(tt) * 128u + (((tt) >= 4 && (u).kind() == K_RETO) ? (long long)(WS_Q - WS_H) - 512 : 0ll))
#define PG8_PB(u, tt) ((u).B + (unsigned)(tt) * 128u + (((tt) >= 4 && (u).kind() == K_RETO) ? (long long)(WS_SALL - WS_VT) - 512 : 0ll))
    Unit cur; int ui = 0;
    if (!S.next(0, cur)) return;
    { const unsigned dl = S.start_delay();
      if (dl) { const unsigned long long t0 = __builtin_amdgcn_s_memrealtime(); while (__builtin_amdgcn_s_memrealtime() - t0 < dl) __builtin_amdgcn_s_sleep(8); } }
    f32x4 acc[2][2][4][2];
#pragma unroll
    for (int a = 0; a < 2; ++a)
#pragma unroll
        for (int b = 0; b < 2; ++b)
#pragma unroll
            for (int m = 0; m < 4; ++m)
#pragma unroll
                for (int n = 0; n < 2; ++n) acc[a][b][m][n] = (f32x4){0.f, 0.f, 0.f, 0.f};
    bf16x8 At[4][2], B0[2][2], B1[2][2];
    {
        const char* cA = cur.A; const char* cB = cur.B; const unsigned la = cur.lda, lb = cur.ldb;
        PG8_STB(PG8_SB(0, 0), cB, lb); PG8_STB(PG8_SB(0, 1), cB + 128u * lb, lb); PG8_STA(PG8_SA(0, 0), cA, la); PG8_STA(PG8_SA(0, 1), cA + 128u * la, la);
        PG8_STB(PG8_SB(1, 0), cB + 128, lb); PG8_STB(PG8_SB(1, 1), cB + 128u * lb + 128, lb); PG8_STA(PG8_SA(1, 0), cA + 128, la); PG8_STA(PG8_SA(1, 1), cA + 128u * la + 128, la);
        if (wr == 1) PG8_BAR;
        PG8_WAIT_V(0); PG8_BAR; PG8_BAR;
    }
#define PG8_BODY(T, REL) do { const int t = (T); const bool last = (REL) ? false : (t == nt - 2); \
            const unsigned la2 = last ? nla : cla, lb2 = last ? nlb : clb; \
              \
            PG8_LDB(B0, 0, 0); PG8_LDB(B1, 0, 1); PG8_SCHED; PG8_LDA(At, 0, 0); \
            if (!(REL)) { const char* a1 = PG8_PA(cur, t + 1); PG8_STA(PG8_SA(1, 1), a1 + 128u * cla, cla); PG8_WAIT_V(8); } \
            PG8_WAIT_L(0); PG8_BAR; PG8_MMA(0, 0, At, B0); PG8_MMA(0, 1, At, B1); PG8_BAR; PG8_SCHED; \
              \
            PG8_LDA(At, 0, 1); \
            { const char* a2 = last ? nA : PG8_PA(cur, t + 2); const char* b2 = last ? nB : PG8_PB(cur, t + 2); \
              PG8_STB(PG8_SB(0, 0), b2, lb2); PG8_STB(PG8_SB(0, 1), b2 + 128u * lb2, lb2); PG8_STA(PG8_SA(0, 0), a2, la2); } \
            if (!(REL)) PG8_WAIT_V(8); \
            PG8_WAIT_L(0); PG8_BAR; PG8_MMA(1, 0, At, B0); PG8_MMA(1, 1, At, B1); PG8_BAR; PG8_SCHED; \
              \
            PG8_LDB(B0, 1, 0); PG8_LDB(B1, 1, 1); PG8_SCHED; PG8_LDA(At, 1, 0); \
            { const char* a2 = last ? nA : PG8_PA(cur, t + 2); PG8_STA(PG8_SA(0, 1), a2 + 128u * la2, la2); } \
            if (!(REL)) PG8_WAIT_V(8); \
            PG8_WAIT_L(0); PG8_BAR; PG8_MMA(0, 0, At, B0); PG8_MMA(0, 1, At, B1); PG8_BAR; PG8_SCHED; \
              \
            PG8_LDA(At, 1, 1); \
            { const char* a3 = last ? nA + 128 : PG8_PA(cur, t + 3); const char* b3 = last ? nB + 128 : PG8_PB(cur, t + 3); \
              PG8_STB(PG8_SB(1, 0), b3, lb2); PG8_STB(PG8_SB(1, 1), b3 + 128u * lb2, lb2); PG8_STA(PG8_SA(1, 0), a3, la2); } \
            PG8_WAIT_V(8); PG8_WAIT_L(0); PG8_BAR; PG8_MMA(1, 0, At, B0); PG8_MMA(1, 1, At, B1); PG8_BAR; PG8_SCHED; } while (0)
    for (;;) {
        const char* nA; const char* nB; unsigned nla, nlb; bool has_next;
        { Unit nx; has_next = S.next(ui + 1, nx); if (!has_next) nx = cur;
          nA = nx.A; nB = nx.B; nla = nx.lda; nlb = nx.ldb; }
        const int nt = cur.nt(); const unsigned cla = cur.lda, clb = cur.ldb;
        PG8_BODY(0, true);
        for (int tt = 2; tt < nt; tt += 2) PG8_BODY(tt, false);
        if (wr == 0) PG8_BAR;
        { const char* nA1 = nA; asm volatile("" : "+s"(nA1));
          PG8_STA(PG8_SA(1, 1), nA1 + 128 + 128u * nla, nla); }
        E(acc, cur, wr, wc, fr, fq, lds);
        if (!has_next) break;
        if (!cur.keep()) {
#pragma unroll
            for (int a = 0; a < 2; ++a)
#pragma unroll
                for (int b = 0; b < 2; ++b)
#pragma unroll
                    for (int m = 0; m < 4; ++m)
#pragma unroll
                        for (int n = 0; n < 2; ++n) acc[a][b][m][n] = (f32x4){0.f, 0.f, 0.f, 0.f};
        }
        ++ui; (void)S.next(ui, cur);
        if (wr == 1) PG8_BAR;
    }
#undef PG8_BODY
    PG8_WAIT_V(0);
    PG8_BAR;
#undef PG8_SA
#undef PG8_SB
#undef PG8_STAGE
#undef PG8_STA
#undef PG8_STB
#undef PG8_LDA
#undef PG8_LDB
#undef PG8_MMA
#undef PG8_WAIT_V
#undef PG8_WAIT_L
#undef PG8_BAR
#undef PG8_SCHED
#undef PG8_PA
#undef PG8_PB
}
}
using pg8::Unit;

template <int PH> struct Sched {
    static constexpr int ph = PH; int G, c; Bufs b; int ibeg, iend;
    __device__ __forceinline__ unsigned start_delay() const {
        return 0u;
    }
    __device__ __forceinline__ bool next(int i, Unit& u) const {
        u.lda = 2048; u.ldb = 2048;
        if constexpr (PH == 1) {
            const int ii = i + ibeg; if (ii >= iend) return false;
            const int x = c & 7, li = ii * (G >> 3) + (c >> 3); if (li >= 442) return false;
            int pm, pn;
            if (li < 26) { const int s_ = li * 8 + x, q = s_ >> 2; pm = 64 + (s_ & 3); pn = q < 16 ? q : (q < 24 ? q + 16 : (q < 40 ? q - 8 : q)); }
            else { const int lp = li - 26; pm = 8 * x + (lp & 7); pn = lp >> 3; }
            const char* hrow = (const char*)b.H() + (size_t)pm * 256 * 2048; const char* wrow = (const char*)b.Win() + (size_t)pn * 256 * 2048;
            u.A = hrow; u.B = wrow; int kind;
            if (pn < 4) kind = pg8::K_RQ; else if (pn < 8) kind = pg8::K_RK;
            else if (pn < 12) { if (pm < 64) { kind = pg8::K_RVT; u.A = wrow; u.B = hrow; } else kind = pg8::K_RV; }
            else if (pn < 16) kind = pg8::K_RG; else if (pn < 24) kind = pg8::K_CA; else if (pn < 32) kind = pg8::K_CB;
            else if (pn < 36) kind = pg8::K_MQ; else if (pn < 40) kind = pg8::K_MG; else kind = pg8::K_GL;
            u.set(kind, pm, pn);
            return true;
        }
        if constexpr (PH == 20) {
            if (c >= 32 || i >= 8) return false;
            u.set(pg8::K_CHAIN, c, i, 4, 0, i < 7 ? 1 : 0); u.lda = 4096; u.ldb = 4096;
            u.A = (const char*)b.Vt() + ((size_t)c * 256 * 2048 + (size_t)i * 256) * 2; u.B = (const char*)b.KTt() + ((size_t)c * 256 * 2048 + (size_t)i * 256) * 2; return true;
        }
        if constexpr (PH == 23) {
            if (c < 80 || c >= 144 || i > 0) return false;
            const int j = c - 80, bb = j >> 3, pn = j & 7;
            const char* mrow = (const char*)b.MN() + (size_t)bb * 256 * 2048; const char* wrow = (const char*)b.Wmkv() + (size_t)pn * 256 * 2048;
            if (pn < 4) { u.set(pg8::K_MK, bb, pn); u.A = mrow; u.B = wrow; } else { u.set(pg8::K_MVT, bb, pn); u.A = wrow; u.B = mrow; }
            return true;
        }
        if constexpr (PH == 21 || PH == 22) {
            int L = -1;
            if constexpr (PH == 21) { if (c >= 80 && c < 144 && i < 4) L = (c - 80) * 4 + i; }
            else { if (c >= 144) { if (i < 2) L = (c - 144) * 2 + i; } else if (c >= 48 && c < 80) { if (i == 0) L = 224 + (c - 48); } }
            if (L < 0) return false;
            const int bh = L >> 3, cc = L & 7, bb = bh >> 2, h = bh & 3;
            const size_t off = ((size_t)(bb * SEQ + cc * 256) * D + h * 256) * 2;
            if constexpr (PH == 21) { u.set(pg8::K_QK, bh, cc, 4); u.A = (const char*)b.Q() + off; u.B = (const char*)b.KT() + off; }
            else { u.set(pg8::K_XS, bh, cc, 4); u.A = (const char*)b.MQ() + off; u.B = (const char*)b.MKb() + ((size_t)(bb * 256) * D + h * 256) * 2; }
            return true;
        }
        if constexpr (PH == 30 || PH == 31) {
            int L = i * G + c;
            if constexpr (PH == 31) { L = 256; if (c >= 144) { if (i < 2) L = (c - 144) * 2 + i; } else if (c >= 48 && c < 80) { if (i == 0) L = 224 + (c - 48); } }
            if (L >= 256) return false;
            const int bh = L >> 3, cc = L & 7, bb = bh >> 2, h = bh & 3;
            const size_t off = ((size_t)(bb * SEQ + cc * 256) * D + h * 256) * 2;
            if constexpr (PH == 30) { u.set(pg8::K_RETO, bh, cc, cc == 0 ? 4 : 8); u.ldb = 4096;
                u.A = (const char*)b.H() + off; u.B = (const char*)b.Vt() + ((size_t)bh * 256 * 2048 + (size_t)cc * 256) * 2; }
            else { u.set(pg8::K_XO, bh, cc, 4); u.ldb = 512; u.A = (const char*)b.MQ() + off; u.B = (const char*)b.MVt() + (size_t)bh * 256 * 256 * 2; }
            return true;
        }
        if constexpr (PH == 24) {
            if (i > 0 || c < 32 || c >= 80) return false;
            const int j = c - 32, s_ = j & 15, br = j >> 4, pm = 64 + (s_ >> 2), pn = s_ & 3;
            u.set(pg8::K_P3S, pm, pn, 16, br, 0);
            const bf16* a = br == 0 ? b.Q() : (br == 1 ? b.GCB() : b.MQ()); const bf16* w = br == 0 ? b.Wro() : (br == 1 ? b.Wco() : b.Wmo());
            u.A = (const char*)a + (size_t)pm * 256 * 2048; u.B = (const char*)w + (size_t)pn * 256 * 2048; return true;
        }
        if constexpr (PH == 4) {
            if (i < 3) { const int x = c & 7, idx = c >> 3, pm = x * 8 + (idx >> 2), pn = idx & 3, br = i;
                u.set(pg8::K_P3A, pm, pn, 16, br, br < 2 ? 1 : 0);
                const bf16* a = br == 0 ? b.Q() : (br == 1 ? b.GCB() : b.MQ()); const bf16* w = br == 0 ? b.Wro() : (br == 1 ? b.Wco() : b.Wmo());
                u.A = (const char*)a + (size_t)pm * 256 * 2048; u.B = (const char*)w + (size_t)pn * 256 * 2048; return true; }
            return false;
        }
        if constexpr (PH == 5 || PH == 52) {
            if (i > 0) return false;
            if (PH == 52 && (c < 32 || c >= 48)) return false;
            const int x = c & 7, idx = c >> 3, pm = PH == 52 ? 64 + ((c - 32) >> 2) : x * 8 + (idx >> 2), pn = PH == 52 ? (c & 3) : (idx & 3);
            u.set(pg8::K_P3B, pm, pn, 16, 0);
            u.A = (const char*)b.H() + (size_t)pm * 256 * 2048; u.B = (const char*)b.Wout() + (size_t)pn * 256 * 2048;
            return true;
        }
        return false;
    }
};

template <int PH, bool DRY = false> struct Epi {
    Bufs bufs; int rt_dry;
    typedef f32x4 Acc[2][2][4][2];
#define EROW(ai, m) (128 * (ai) + 64 * wr + 16 * (m) + fr)
#define EPI_SEQ() do { asm volatile("" ::: "memory"); __builtin_amdgcn_sched_barrier(0); } while (0)
#define EPI_LANDED(n) do { asm volatile("s_waitcnt vmcnt(" #n ")" ::: "memory"); __builtin_amdgcn_sched_barrier(0); } while (0)
#define EPI_FENCE() do { asm volatile("s_waitcnt vmcnt(0)" ::: "memory"); __builtin_amdgcn_sched_barrier(0); } while (0)
#define EPI_LOOP_AM _Pragma("unroll") for (int ai = 0; ai < 2; ++ai) _Pragma("unroll") for (int m = 0; m < 4; ++m)
#define EPI_STEP() do { asm volatile("" ::: "memory"); __builtin_amdgcn_sched_barrier(0); } while (0)
    static __device__ __forceinline__ f32x4 bits4(u32x4 w) { return __builtin_bit_cast(f32x4, w); }
    static __device__ __forceinline__ u32x4 ubits4(f32x4 w) { return __builtin_bit_cast(u32x4, w); }
    __device__ __forceinline__ void store_packed(const Acc& acc, bf16* base, size_t ld, int wr, int wc, int fr, int fq) const {
        const int cl = 32 * wc + 8 * fq;
        EPI_LOOP_AM { EPI_STEP(); bf16* rowp = base + (size_t)EROW(ai, m) * ld + cl;
#pragma unroll
            for (int bj = 0; bj < 2; ++bj) *(u32x4*)(rowp + 128 * bj) = ubits4(acc[ai][bj][m][0]); }
    }
    template <bool ISK> __device__ __forceinline__ void rope(const Bufs& b, Acc& acc, const Unit& u, int wr, int wc, int fr, int fq) const {
        const int head = u.pn() & 3, cl = 32 * wc + 8 * fq; const float ch = b.clg(head); const bool prompt = u.pm() < 64;
#pragma unroll
        for (int am = 0; am < 4; ++am) { EPI_STEP();
            const int ai = am >> 1; f32x4 cs[2][4];
#pragma unroll
            for (int mm = 0; mm < 2; ++mm) { const int m = 2 * (am & 1) + mm; const int r = u.pm() * 256 + EROW(ai, m); const int pidx = prompt ? (r & (SEQ - 1)) : SEQ + (r & 7);
                const float* cp = b.cosT() + pidx * 128 + cl; const float* sp = b.sinT() + pidx * 128 + cl;
                cs[mm][0] = *(const f32x4*)cp; cs[mm][1] = *(const f32x4*)(cp + 4); cs[mm][2] = *(const f32x4*)sp; cs[mm][3] = *(const f32x4*)(sp + 4); }
#pragma unroll
            for (int mm = 0; mm < 2; ++mm) { const int m = 2 * (am & 1) + mm; const int r = u.pm() * 256 + EROW(ai, m);
                const f32x4 c0 = cs[mm][0], c1 = cs[mm][1], s0 = cs[mm][2], s1 = cs[mm][3];
                const f32x4 x1a = acc[ai][0][m][0], x1b = acc[ai][0][m][1], x2a = acc[ai][1][m][0], x2b = acc[ai][1][m][1];
                f32x4 o1a = x1a * c0 - x2a * s0, o1b = x1b * c1 - x2b * s1, o2a = x1a * s0 + x2a * c0, o2b = x1b * s1 + x2b * c1;
                if (ISK) { float sc = 0.0625f; if (prompt) sc *= __builtin_amdgcn_exp2f((float)((r & 255) + 1) * ch); o1a *= sc; o1b *= sc; o2a *= sc; o2b *= sc; }
                acc[ai][0][m][0] = bits4(pack8(o1a, o1b)); acc[ai][1][m][0] = bits4(pack8(o2a, o2b)); }
        }
        EPI_SEQ();
        if (ISK && prompt) {
            EPI_LOOP_AM { EPI_STEP(); const int r = u.pm() * 256 + EROW(ai, m);
                const float s2 = __builtin_amdgcn_exp2f((float)((r & (SEQ - 1)) & ~255) * ch);
                bf16* t = b.KTt() + ((size_t)(((r >> 11) * 4 + head) * 256 + cl)) * SEQ + (r & (SEQ - 1));
#pragma unroll
                for (int bj = 0; bj < 2; ++bj) { f32x4 x0, x1; unpack8(ubits4(acc[ai][bj][m][0]), x0, x1); const u32x4 w = pack8(x0 * s2, x1 * s2);
#pragma unroll
                    for (int e = 0; e < 8; ++e) t[(size_t)(128 * bj + e) * SEQ] = (bf16)(w[e >> 1] >> (16 * (e & 1))); } }
        }
        store_packed(acc, (ISK ? b.KT() : b.Q()) + (size_t)u.pm() * 256 * D + head * 256, D, wr, wc, fr, fq); EPI_LANDED(16);
    }
    template <int MODE> __device__ __forceinline__ void store_tile(Acc& acc, bf16* base  , size_t ld, const float* bias, int wr, int wc, int fr, int fq) const {
        const int cl = 32 * wc + 8 * fq;
        f32x4 bv[2][2];
        if (MODE == 2) {
#pragma unroll
            for (int bj = 0; bj < 2; ++bj) { bv[bj][0] = *(const f32x4*)(bias + 128 * bj + cl); bv[bj][1] = *(const f32x4*)(bias + 128 * bj + cl + 4); } }
        EPI_LOOP_AM {
#pragma unroll
            for (int bj = 0; bj < 2; ++bj) { f32x4 v0 = acc[ai][bj][m][0], v1 = acc[ai][bj][m][1];
                if (MODE == 1) { v0 = silu4(v0); v1 = silu4(v1); }
                if (MODE == 2) { v0 = sigm4(v0 + bv[bj][0]); v1 = sigm4(v1 + bv[bj][1]);
#pragma unroll
                    for (int e = 0; e < 4; ++e) { v0[e] = fmaxf(v0[e], 7.8886090522101181e-31f); v1[e] = fmaxf(v1[e], 7.8886090522101181e-31f); } }
                acc[ai][bj][m][0] = bits4(pack8(v0, v1)); } }
        EPI_SEQ();
        store_packed(acc, base, ld, wr, wc, fr, fq); EPI_LANDED(16);
    }
    __device__ __forceinline__ void operator()(Acc& acc, const Unit& u, int wr, int wc, int fr, int fq, LAS unsigned char* lds) const {
        asm volatile("" : "+v"(fr), "+v"(fq), "+s"(wr), "+s"(wc));
        if (DRY && rt_dry) { asm volatile("s_waitcnt vmcnt(0)" ::: "memory"); return; }
        Bufs b = bufs; asm volatile("" : "+s"(b.ka));
        const int cl = 32 * wc + 8 * fq;
        switch (u.kind()) {
        case pg8::K_RQ: if constexpr (PH == 1) { rope<false>(b, acc, u, wr, wc, fr, fq); } break;
        case pg8::K_RK: if constexpr (PH == 1) { rope<true>(b, acc, u, wr, wc, fr, fq); } break;
        case pg8::K_RV: if constexpr (PH == 1) { store_tile<0>(acc, b.Vs() + (size_t)(u.pm() * 256 - MP) * D + (u.pn() - 8) * 256, D, nullptr, wr, wc, fr, fq); } break;
        case pg8::K_RVT: if constexpr (PH == 1) { store_tile<0>(acc, b.Vt() + (size_t)(((u.pm() >> 3) * 4 + (u.pn() - 8)) * 256) * SEQ + (u.pm() & 7) * 256, SEQ, nullptr, wr, wc, fr, fq); } break;
        case pg8::K_RG: if constexpr (PH == 1) { store_tile<1>(acc, b.RG() + (size_t)u.pm() * 256 * D + (u.pn() - 12) * 256, D, nullptr, wr, wc, fr, fq); } break;
        case pg8::K_MQ: if constexpr (PH == 1) { store_tile<0>(acc, b.MQ() + (size_t)u.pm() * 256 * D + (u.pn() - 32) * 256, D, nullptr, wr, wc, fr, fq); } break;
        case pg8::K_MG: if constexpr (PH == 1) { store_tile<1>(acc, b.MG() + (size_t)u.pm() * 256 * D + (u.pn() - 36) * 256, D, nullptr, wr, wc, fr, fq); } break;
        case pg8::K_GL: if constexpr (PH == 1) { const int gi = u.pn() - 40; store_tile<2>(acc, b.GATES() + (size_t)(gi >> 2) * MT * D + (size_t)u.pm() * 256 * D + (gi & 3) * 256, D, b.b_gate() + gi * 256, wr, wc, fr, fq); } break;
        case pg8::K_CA: if constexpr (PH == 1) {
            const int t = u.pn() - 16;
            EPI_LOOP_AM { acc[ai][0][m][0] *= acc[ai][1][m][0]; acc[ai][0][m][1] *= acc[ai][1][m][1]; }
            EPI_SEQ();
            EPI_LOOP_AM { EPI_STEP(); const int r = u.pm() * 256 + EROW(ai, m);
                const f32x4 p0 = acc[ai][0][m][0], p1 = acc[ai][0][m][1];
                *(u32x4*)(b.PRE() + (size_t)r * D + 128 * t + cl) = pack8(p0, p1);
                float* st = nullptr;
                if (u.pm() < 64) { const int tt = r & (SEQ - 1); if (tt >= SEQ - 2) st = b.out + O_CP + (size_t)((r >> 11) * 2 + (tt - (SEQ - 2))) * D; }
                else { const int rs = r - MP, tt = rs & 7; if (tt >= 6) st = b.out + O_CS + (size_t)((rs >> 3) * 2 + (tt - 6)) * D; }
                if (st) { *(f32x4*)(st + 128 * t + cl) = p0; *(f32x4*)(st + 128 * t + cl + 4) = p1; } }
            EPI_LANDED(8);
        } break;
        case pg8::K_CB: if constexpr (PH == 1) {
            const int t = u.pn() - 24;
            EPI_LOOP_AM { acc[ai][0][m][0] = bits4(pack8(acc[ai][0][m][0] * silu4(acc[ai][1][m][0]), acc[ai][0][m][1] * silu4(acc[ai][1][m][1]))); }
            EPI_SEQ();
            EPI_LOOP_AM { EPI_STEP(); *(u32x4*)(b.GCB() + (size_t)(u.pm() * 256 + EROW(ai, m)) * D + 128 * t + cl) = ubits4(acc[ai][0][m][0]); }
            EPI_LANDED(8);
        } break;
        case pg8::K_MK: if constexpr (PH == 23) {
            EPI_FENCE();
            EPI_LOOP_AM { EPI_STEP(); const size_t ro = (size_t)(u.pm() * 256 + EROW(ai, m)) * D + u.pn() * 256 + cl;
#pragma unroll
                for (int bj = 0; bj < 2; ++bj) { const f32x4 v0 = acc[ai][bj][m][0], v1 = acc[ai][bj][m][1];
                    *(f32x4*)(b.out + O_MK + ro + 128 * bj) = v0; *(f32x4*)(b.out + O_MK + ro + 128 * bj + 4) = v1; *(u32x4*)(b.MKb() + ro + 128 * bj) = pack8(v0, v1); } }
        } break;
        case pg8::K_MVT: if constexpr (PH == 23) {
            const int h = u.pn() - 4;
            EPI_FENCE();
            EPI_LOOP_AM { EPI_STEP(); const int f = EROW(ai, m);
#pragma unroll
                for (int bj = 0; bj < 2; ++bj) { const f32x4 v0 = acc[ai][bj][m][0], v1 = acc[ai][bj][m][1]; const int mm = 128 * bj + cl;
                    *(u32x4*)(b.MVt() + (size_t)((u.pm() * 4 + h) * 256 + f) * 256 + mm) = pack8(v0, v1);
                    float* o = b.out + O_MV + (size_t)(u.pm() * 256 + mm) * D + h * 256 + f;
#pragma unroll
                    for (int e = 0; e < 4; ++e) { o[(size_t)e * D] = v0[e]; o[(size_t)(4 + e) * D] = v1[e]; } } }
        } break;
        case pg8::K_QK: if constexpr (PH == 21) {
            const int bh = u.pm(), bb = bh >> 2, h = bh & 3;
            EPI_LOOP_AM { const int il = EROW(ai, m);
#pragma unroll
                for (int bj = 0; bj < 2; ++bj) { f32x4 v0 = acc[ai][bj][m][0], v1 = acc[ai][bj][m][1]; const int j0 = 128 * bj + cl;
                    const int dd = il - j0;
#pragma unroll
                    for (int e = 0; e < 4; ++e) { v0[e] *= (float)min(max(dd - e + 1, 0), 1); v1[e] *= (float)min(max(dd - e - 3, 0), 1); }
                    acc[ai][bj][m][0] = bits4(pack8(v0, v1)); } }
            EPI_SEQ();
            store_packed(acc, b.H() + (size_t)(bb * SEQ + u.pn() * 256) * D + h * 256, D, wr, wc, fr, fq); EPI_LANDED(16);
        } break;
        case pg8::K_CHAIN: if constexpr (PH == 20) {
            const int bh = u.pm(), h = bh & 3, step = u.pn(); const float gs = __builtin_amdgcn_exp2f(-256.0f * (float)(step + 1) * b.clg(h));
            EPI_SEQ();
            EPI_LOOP_AM { EPI_STEP(); const int f = EROW(ai, m);
#pragma unroll
                for (int bj = 0; bj < 2; ++bj) { const f32x4 v0 = acc[ai][bj][m][0] * gs, v1 = acc[ai][bj][m][1] * gs; const int dk = 128 * bj + cl;
                    if (step < 7) *(u32x4*)(b.SALL() + (size_t)(bh * 256 + f) * SEQ + (step + 1) * 256 + dk) = pack8(v0, v1);
                    else { float* o = b.out + O_RP + (size_t)(bh * 256 + dk) * 256 + f;
#pragma unroll
                        for (int e = 0; e < 4; ++e) { o[(size_t)e * 256] = v0[e]; o[(size_t)(4 + e) * 256] = v1[e]; } } } }
            EPI_LANDED(16);
        } break;
        case pg8::K_RETO: if constexpr (PH == 30) {
            const int bh = u.pm(), bb = bh >> 2, h = bh & 3; const float ch = b.clg(h);
            LAS float* X = (LAS float*)(lds + LDS_X);
            const size_t tile0 = (size_t)(bb * SEQ + u.pn() * 256) * D + h * 256;
            EPI_LOOP_AM { const int il = EROW(ai, m); const float sc = __builtin_amdgcn_exp2f(-(float)(il + 1) * ch); float ss = 0.f;
#pragma unroll
                for (int bj = 0; bj < 2; ++bj)
#pragma unroll
                    for (int n = 0; n < 2; ++n) { f32x4 v = acc[ai][bj][m][n] * sc; acc[ai][bj][m][n] = v; ss += (v[0] * v[0] + v[1] * v[1]) + (v[2] * v[2] + v[3] * v[3]); }
                ss += __shfl_xor(ss, 16); ss += __shfl_xor(ss, 32);
                if (fq == 0) X[il * 4 + wc] = ss; }
            LDS_WAIT(); __builtin_amdgcn_s_barrier(); asm volatile("" ::: "memory");
#pragma unroll
            for (int ai = 0; ai < 2; ++ai) { EPI_STEP();
                u32x4 rg[4][2];
#pragma unroll
                for (int m = 0; m < 4; ++m)
#pragma unroll
                    for (int bj = 0; bj < 2; ++bj) rg[m][bj] = *(const u32x4*)(b.RG() + tile0 + (size_t)EROW(ai, m) * D + cl + 128 * bj);
#pragma unroll
                for (int m = 0; m < 4; ++m) { const int il = EROW(ai, m);
                    const f32x4 t = *(const LAS f32x4*)(X + il * 4); const float rs = __builtin_amdgcn_rsqf(((t[0] + t[1]) + (t[2] + t[3])) * (1.0f / 256.0f) + EPS);
#pragma unroll
                    for (int bj = 0; bj < 2; ++bj) { f32x4 r0, r1; unpack8(rg[m][bj], r0, r1);
                        acc[ai][bj][m][0] = bits4(pack8(acc[ai][bj][m][0] * rs * r0, acc[ai][bj][m][1] * rs * r1)); } } }
            EPI_SEQ();
            store_packed(acc, b.Q() + tile0, D, wr, wc, fr, fq); EPI_LANDED(16);
            LDS_WAIT(); __builtin_amdgcn_s_barrier(); asm volatile("" ::: "memory");
        } break;
        case pg8::K_XS: if constexpr (PH == 22) {
            const int bh = u.pm(), bb = bh >> 2, h = bh & 3; const float C = 0.0625f * LOG2E;
            LAS f32x2* X = (LAS f32x2*)(lds + LDS_X);
            float ml[2][4];
            EPI_LOOP_AM { EPI_STEP(); const int il = EROW(ai, m); float mx = -3.0e38f;
#pragma unroll
                for (int bj = 0; bj < 2; ++bj)
#pragma unroll
                    for (int n = 0; n < 2; ++n) { const f32x4 v = acc[ai][bj][m][n] * C; acc[ai][bj][m][n] = v; mx = fmaxf(fmaxf(mx, fmaxf(v[0], v[1])), fmaxf(v[2], v[3])); }
                mx = fmaxf(mx, __shfl_xor(mx, 16)); mx = fmaxf(mx, __shfl_xor(mx, 32)); float l = 0.f;
#pragma unroll
                for (int bj = 0; bj < 2; ++bj)
#pragma unroll
                    for (int n = 0; n < 2; ++n) { f32x4 v = acc[ai][bj][m][n];
#pragma unroll
                        for (int e = 0; e < 4; ++e) { v[e] = __builtin_amdgcn_exp2f(v[e] - mx); l += v[e]; }
                        acc[ai][bj][m][n] = v; }
                l += __shfl_xor(l, 16); l += __shfl_xor(l, 32); ml[ai][m] = mx;
                if (fq == 0) X[il * 4 + wc] = (f32x2){mx, l}; }
            LDS_WAIT(); __builtin_amdgcn_s_barrier(); asm volatile("" ::: "memory");
            EPI_LOOP_AM { EPI_STEP(); const int il = EROW(ai, m);
                const f32x2 t0 = X[il * 4 + 0], t1 = X[il * 4 + 1], t2 = X[il * 4 + 2], t3 = X[il * 4 + 3];
                const float M = fmaxf(fmaxf(t0.x, t1.x), fmaxf(t2.x, t3.x));
                const float L = t0.y * __builtin_amdgcn_exp2f(t0.x - M) + t1.y * __builtin_amdgcn_exp2f(t1.x - M) + t2.y * __builtin_amdgcn_exp2f(t2.x - M) + t3.y * __builtin_amdgcn_exp2f(t3.x - M);
                const float f = __builtin_amdgcn_exp2f(ml[ai][m] - M) * __builtin_amdgcn_rcpf(L);
#pragma unroll
                for (int bj = 0; bj < 2; ++bj) acc[ai][bj][m][0] = bits4(pack8(acc[ai][bj][m][0] * f, acc[ai][bj][m][1] * f)); }
            EPI_SEQ();
            store_packed(acc, b.MQ() + (size_t)(bb * SEQ + u.pn() * 256) * D + h * 256, D, wr, wc, fr, fq); EPI_LANDED(16);
            LDS_WAIT(); __builtin_amdgcn_s_barrier(); asm volatile("" ::: "memory");
        } break;
        case pg8::K_XO: if constexpr (PH == 31) {
            const int bh = u.pm(), bb = bh >> 2, h = bh & 3; const size_t tile0 = (size_t)(bb * SEQ + u.pn() * 256) * D + h * 256;
#pragma unroll
            for (int ai = 0; ai < 2; ++ai) { EPI_STEP();
                u32x4 mg[4][2];
#pragma unroll
                for (int m = 0; m < 4; ++m)
#pragma unroll
                    for (int bj = 0; bj < 2; ++bj) mg[m][bj] = *(const u32x4*)(b.MG() + tile0 + (size_t)EROW(ai, m) * D + cl + 128 * bj);
#pragma unroll
                for (int m = 0; m < 4; ++m)
#pragma unroll
                    for (int bj = 0; bj < 2; ++bj) { f32x4 g0, g1; unpack8(mg[m][bj], g0, g1);
                        acc[ai][bj][m][0] = bits4(pack8(acc[ai][bj][m][0] * g0, acc[ai][bj][m][1] * g1)); } }
            EPI_SEQ();
            store_packed(acc, b.MQ() + tile0, D, wr, wc, fr, fq); EPI_LANDED(16);
        } break;
        case pg8::K_P3A: if constexpr (PH == 4) {
            const int br = u.aux();
            const size_t tile0 = (size_t)u.pm() * 256 * D + u.pn() * 256;
            const bf16* gb = b.GATES() + (size_t)br * MT * D + tile0 + cl;
            if (br < 2) {
#pragma unroll
                for (int ai = 0; ai < 2; ++ai) { EPI_STEP();
                    u32x4 ga[4][2], gn[4][2];
#pragma unroll
                    for (int m = 0; m < 4; ++m)
#pragma unroll
                        for (int bj = 0; bj < 2; ++bj) { const bf16* gp = gb + (size_t)EROW(ai, m) * D + 128 * bj; ga[m][bj] = *(const u32x4*)gp; gn[m][bj] = *(const u32x4*)(gp + (size_t)MT * D); }
#pragma unroll
                    for (int m = 0; m < 4; ++m)
#pragma unroll
                        for (int bj = 0; bj < 2; ++bj) { f32x4 g0, g1, h0, h1; unpack8(ga[m][bj], g0, g1); unpack8(gn[m][bj], h0, h1);
#pragma unroll
                            for (int e = 0; e < 4; ++e) { g0[e] *= __builtin_amdgcn_rcpf(h0[e]); g1[e] *= __builtin_amdgcn_rcpf(h1[e]); }
                            acc[ai][bj][m][0] *= g0; acc[ai][bj][m][1] *= g1; } }
            } else {
                u32x4 ga[2][4][2];
                EPI_LOOP_AM {
#pragma unroll
                    for (int bj = 0; bj < 2; ++bj) ga[ai][m][bj] = *(const u32x4*)(gb + (size_t)EROW(ai, m) * D + 128 * bj); }
                EPI_LOOP_AM {
#pragma unroll
                    for (int bj = 0; bj < 2; ++bj) { f32x4 g0, g1; unpack8(ga[ai][m][bj], g0, g1); acc[ai][bj][m][0] = bits4(pack8(acc[ai][bj][m][0] * g0, acc[ai][bj][m][1] * g1)); } }
            }
            if (br < 2) { EPI_FENCE(); break; }
            EPI_SEQ();
            store_packed(acc, b.H() + tile0, D, wr, wc, fr, fq); EPI_LANDED(16);
        } break;
        case pg8::K_P3B: if constexpr (PH == 5 || PH == 52) {
            const int pm = u.pm(), pn = u.pn();
            const float* xb = pm < 64 ? b.xp() + (size_t)pm * 256 * D : b.xs() + (size_t)(pm - 64) * 256 * D;
            LAS float* X = (LAS float*)(lds + LDS_X);
#pragma unroll
            for (int ai = 0; ai < 2; ++ai) { EPI_STEP();
                f32x4 xv[4][2][2];
#pragma unroll
                for (int m = 0; m < 4; ++m) { const float* xr = xb + (size_t)EROW(ai, m) * D + pn * 256 + cl;
#pragma unroll
                    for (int bj = 0; bj < 2; ++bj) { xv[m][bj][0] = *(const f32x4*)(xr + 128 * bj); xv[m][bj][1] = *(const f32x4*)(xr + 128 * bj + 4); } }
#pragma unroll
                for (int m = 0; m < 4; ++m) { float ss = 0.f;
#pragma unroll
                    for (int bj = 0; bj < 2; ++bj)
#pragma unroll
                        for (int n = 0; n < 2; ++n) { const f32x4 v = acc[ai][bj][m][n] + xv[m][bj][n]; acc[ai][bj][m][n] = v; ss += (v[0] * v[0] + v[1] * v[1]) + (v[2] * v[2] + v[3] * v[3]); }
                    ss += __shfl_xor(ss, 16); ss += __shfl_xor(ss, 32);
                    if (fq == 0) X[EROW(ai, m) * 4 + wc] = ss; } }
            LDS_WAIT(); __builtin_amdgcn_s_barrier(); asm volatile("" ::: "memory");
            const int t = (wr * 4 + wc) * 64 + fq * 16 + fr;
            unsigned* cnt = b.ctl() + CW_PCNT + 16 * pm; float* part = (float*)(b.ctl() + CW_PART) + (size_t)pm * 1024;
            if (t < 256) { const f32x4 s4 = *(const LAS f32x4*)(X + t * 4); part[pn * 256 + t] = (s4[0] + s4[1]) + (s4[2] + s4[3]); }
            asm volatile("s_waitcnt vmcnt(0)" ::: "memory"); __builtin_amdgcn_s_barrier();
            if (t == 0) { __builtin_amdgcn_fence(__ATOMIC_RELEASE, "agent"); asm volatile("s_waitcnt vmcnt(0)" ::: "memory"); (void)__hip_atomic_fetch_add(cnt, 1u, __ATOMIC_RELAXED, __HIP_MEMORY_SCOPE_AGENT);
                unsigned sp = 0; while (__hip_atomic_load(cnt, __ATOMIC_RELAXED, __HIP_MEMORY_SCOPE_AGENT) < 4u && ++sp < (1u << 22)) __builtin_amdgcn_s_sleep(2);
                __builtin_amdgcn_fence(__ATOMIC_ACQUIRE, "agent"); asm volatile("s_waitcnt vmcnt(0)" ::: "memory"); }
            __builtin_amdgcn_s_barrier(); asm volatile("" ::: "memory");
            if (t < 256) { float s = 0.f;
#pragma unroll
                for (int j = 0; j < 4; ++j) s += __uint_as_float(__hip_atomic_load((unsigned*)part + j * 256 + t, __ATOMIC_RELAXED, __HIP_MEMORY_SCOPE_AGENT));
                X[1024 + t] = 1.0f / sqrtf(s * (1.f / D) + EPS); }
            LDS_WAIT(); __builtin_amdgcn_s_barrier(); asm volatile("" ::: "memory");
            f32x4 gg[2][2];
#pragma unroll
            for (int bj = 0; bj < 2; ++bj) { gg[bj][0] = *(const f32x4*)(b.fin_g() + pn * 256 + cl + 128 * bj); gg[bj][1] = *(const f32x4*)(b.fin_g() + pn * 256 + cl + 128 * bj + 4); }
            EPI_LOOP_AM { const float rs = X[1024 + EROW(ai, m)];
#pragma unroll
                for (int bj = 0; bj < 2; ++bj) { acc[ai][bj][m][0] = acc[ai][bj][m][0] * rs * gg[bj][0]; acc[ai][bj][m][1] = acc[ai][bj][m][1] * rs * gg[bj][1]; } }
            EPI_SEQ();
            float* dst = b.out + O_Y + (size_t)pm * 256 * D + pn * 256 + cl;
            EPI_LOOP_AM { EPI_STEP(); float* rowp = dst + (size_t)EROW(ai, m) * D;
#pragma unroll
                for (int bj = 0; bj < 2; ++bj) { *(f32x4*)(rowp + 128 * bj) = acc[ai][bj][m][0]; *(f32x4*)(rowp + 128 * bj + 4) = acc[ai][bj][m][1]; } }
            EPI_LANDED(16);
        } break;
        case pg8::K_P3S: if constexpr (PH == 24) {
            const int br = u.aux(); const size_t tile0 = (size_t)u.pm() * 256 * D + u.pn() * 256;
            const bf16* gb = b.GATES() + (size_t)br * MT * D + tile0 + cl;
            u32x4 ga[2][4][2];
            EPI_LOOP_AM {
#pragma unroll
                for (int bj = 0; bj < 2; ++bj) ga[ai][m][bj] = *(const u32x4*)(gb + (size_t)EROW(ai, m) * D + 128 * bj); }
            EPI_LOOP_AM {
#pragma unroll
                for (int bj = 0; bj < 2; ++bj) { f32x4 g0, g1; unpack8(ga[ai][m][bj], g0, g1); acc[ai][bj][m][0] = bits4(pack8(acc[ai][bj][m][0] * g0, acc[ai][bj][m][1] * g1)); } }
            EPI_SEQ();
            store_packed(acc, b.GS() + ((size_t)br * MS + (size_t)(u.pm() - 64) * 256) * D + u.pn() * 256, D, wr, wc, fr, fq); EPI_LANDED(16);
            volatile LAS unsigned* XI = (volatile LAS unsigned*)(lds + LDS_X);
            const int t = (wr * 4 + wc) * 64 + fq * 16 + fr, tix = (u.pm() - 64) * 4 + u.pn();
            asm volatile("s_waitcnt vmcnt(0)" ::: "memory"); __builtin_amdgcn_s_barrier();
            if (t == 0) { __builtin_amdgcn_fence(__ATOMIC_RELEASE, "agent"); asm volatile("s_waitcnt vmcnt(0)" ::: "memory");
                XI[0] = __hip_atomic_fetch_add(b.ctl() + CW_TCNT + tix, 1u, __ATOMIC_RELAXED, __HIP_MEMORY_SCOPE_AGENT); }
            LDS_WAIT(); __builtin_amdgcn_s_barrier(); asm volatile("" ::: "memory");
            if (XI[0] == 2u) {
                __builtin_amdgcn_fence(__ATOMIC_ACQUIRE, "agent"); asm volatile("s_waitcnt vmcnt(0)" ::: "memory");
                EPI_LOOP_AM {
#pragma unroll
                    for (int bj = 0; bj < 2; ++bj) { f32x4 a0, a1; unpack8(ubits4(acc[ai][bj][m][0]), a0, a1); acc[ai][bj][m][0] = a0; acc[ai][bj][m][1] = a1; } }
#pragma unroll
                for (int ob = 0; ob < 3; ++ob) { if (ob == br) continue;
                    const bf16* go = b.GS() + ((size_t)ob * MS + (size_t)(u.pm() - 64) * 256) * D + u.pn() * 256 + cl;
                    u32x4 w[2][4][2];
                    EPI_STEP();
                    EPI_LOOP_AM {
#pragma unroll
                        for (int bj = 0; bj < 2; ++bj) w[ai][m][bj] = *(const u32x4*)(go + (size_t)EROW(ai, m) * D + 128 * bj); }
                    EPI_LOOP_AM {
#pragma unroll
                        for (int bj = 0; bj < 2; ++bj) { f32x4 o0, o1; unpack8(w[ai][m][bj], o0, o1); acc[ai][bj][m][0] += o0; acc[ai][bj][m][1] += o1; } } }
                EPI_LOOP_AM {
#pragma unroll
                    for (int bj = 0; bj < 2; ++bj) acc[ai][bj][m][0] = bits4(pack8(acc[ai][bj][m][0], acc[ai][bj][m][1])); }
                EPI_SEQ();
                store_packed(acc, b.H() + tile0, D, wr, wc, fr, fq);
                asm volatile("s_waitcnt vmcnt(0)" ::: "memory"); __builtin_amdgcn_s_barrier();
                if (t == 0) { __builtin_amdgcn_fence(__ATOMIC_RELEASE, "agent"); asm volatile("s_waitcnt vmcnt(0)" ::: "memory");
                    (void)__hip_atomic_fetch_add(b.ctl() + CW_SCNT + 16 * (u.pm() - 64), 1u, __ATOMIC_RELAXED, __HIP_MEMORY_SCOPE_AGENT); }
            }
        } break;
        default: break;
        }
        if constexpr (PH == 1) {
            if (u.pm() >= 64 && u.pn() < 40) {
                asm volatile("s_waitcnt vmcnt(0)" ::: "memory"); __builtin_amdgcn_s_barrier();
                if (wr == 0 && wc == 0 && fr == 0 && fq == 0) { __builtin_amdgcn_fence(__ATOMIC_RELEASE, "agent"); asm volatile("s_waitcnt vmcnt(0)" ::: "memory"); (void)__hip_atomic_fetch_add(b.ctl() + CW_SREADY, 1u, __ATOMIC_RELAXED, __HIP_MEMORY_SCOPE_AGENT); }
            }
        }
    }
#undef EROW
#undef EPI_FENCE
#undef EPI_LOOP_AM
#undef EPI_STEP
};

#define XB_TMO      128
#define XB_XCNT(j)  (256  + 64 * (j))
#define XB_XSUB(j)  (1280 + 64 * (j))
#define XB_XGEN(j)  (2304 + 64 * (j))
#define XB_TOP      3328
#define XB_TOPGEN   3392
#define XCD_BAR_WORDS 3456
#define XB_SPIN_CAP (1u << 18)
__device__ __forceinline__ unsigned xb_ld(unsigned* p)              { return __hip_atomic_load(p, __ATOMIC_RELAXED, __HIP_MEMORY_SCOPE_AGENT); }
__device__ __forceinline__ unsigned xb_add(unsigned* p, unsigned v) { return __hip_atomic_fetch_add(p, v, __ATOMIC_RELAXED, __HIP_MEMORY_SCOPE_AGENT); }
__device__ __forceinline__ unsigned xb_xcc_id() { return (unsigned)__builtin_amdgcn_s_getreg((3 << 11) | 20) & 0xFu; }
#define XB_SPIN(cond, bar) do { unsigned _sp = 0; while (cond) { __builtin_amdgcn_s_sleep(1); \
    if ((++_sp & 255u) == 0u) { if (xb_ld(&(bar)[XB_TMO])) break; if (_sp > XB_SPIN_CAP) { atomicAdd(&(bar)[XB_TMO], 1u); break; } } } } while (0)
struct XcdBarrier { unsigned* bar; unsigned x; volatile LAS unsigned* st; };
__device__ __forceinline__ XcdBarrier xcd_barrier_post(unsigned* bar, volatile LAS unsigned* st) {
    XcdBarrier b; b.bar = bar; b.x = xb_xcc_id(); b.st = st;
    if (threadIdx.x == 0) (void)xb_add(&bar[XB_XCNT(b.x)], 1u);
    return b;
}
__device__ __forceinline__ void xcd_barrier_complete(unsigned* bar, unsigned x, unsigned& nloc, unsigned& nx) {
    const unsigned G = gridDim.x * gridDim.y * gridDim.z;
    unsigned sum, cnt, mine, sp = 0u;
    for (;;) {
        sum = 0u; cnt = 0u; mine = 0u;
#pragma unroll
        for (unsigned j = 0; j < 16; ++j) { const unsigned c = xb_ld(&bar[XB_XCNT(j)]); sum += c; cnt += (c > 0u) ? 1u : 0u; mine = (j == x) ? c : mine; }
        if (sum == G) break;
        __builtin_amdgcn_s_sleep(1);
        if ((++sp & 255u) == 0u) { if (xb_ld(&bar[XB_TMO])) break; if (sp > XB_SPIN_CAP) { atomicAdd(&bar[XB_TMO], 1u); break; } }
    }
    nloc = mine > 0u ? mine : 1u; nx = cnt > 0u ? cnt : 1u;
}
__device__ __forceinline__ void xcd_barrier(const XcdBarrier& b, unsigned* ready = nullptr) {
    asm volatile("s_waitcnt vmcnt(0)" ::: "memory");
    __syncthreads();
    if (threadIdx.x == 0) {
        unsigned* bar = b.bar;
        if (ready) {
            unsigned sp = 0; while (xb_ld(ready) != 1u && ++sp < (1u << 22)) __builtin_amdgcn_s_sleep(2);
            __builtin_amdgcn_fence(__ATOMIC_ACQUIRE, "agent"); asm volatile("s_waitcnt vmcnt(0)" ::: "memory");
            (void)xb_add(&bar[XB_XCNT(b.x)], 1u); }
        __builtin_amdgcn_s_waitcnt(0);
        unsigned nloc = b.st[0], nx = b.st[1];
        if (nloc == 0u) { xcd_barrier_complete(bar, b.x, nloc, nx); b.st[0] = nloc; b.st[1] = nx; }
        const unsigned old = xb_add(&bar[XB_XSUB(b.x)], 1u);
        const unsigned gen = old / nloc;
        if (old + 1u == (gen + 1u) * nloc) {
            __builtin_amdgcn_fence(__ATOMIC_RELEASE, "agent");
            asm volatile("s_waitcnt vmcnt(0)" ::: "memory");
            const unsigned og = xb_add(&bar[XB_TOP], 1u);
            const unsigned tg = og / nx;
            if (og + 1u == (tg + 1u) * nx) xb_add(&bar[XB_TOPGEN], 1u);
            else XB_SPIN(xb_ld(&bar[XB_TOPGEN]) == tg, bar);
            __builtin_amdgcn_fence(__ATOMIC_ACQUIRE, "agent");
            xb_add(&bar[XB_XGEN(b.x)], 1u);
            asm volatile("s_waitcnt vmcnt(0)" ::: "memory");
        } else {
            XB_SPIN(xb_ld(&bar[XB_XGEN(b.x)]) == gen, bar);
            __builtin_amdgcn_fence(__ATOMIC_ACQUIRE, "agent");
            asm volatile("s_waitcnt vmcnt(0)" ::: "memory");
        }
    }
    __syncthreads();
}

__device__ __forceinline__ void p0_transpose_item(const float* W, int K, int N, bf16* WT, int src_col0, int src_col1, int dst_row0, int k0, LAS float* scr, int lane, const float* kscale = nullptr) {
    const int c4 = (lane & 15) * 4, kr = lane >> 4;
    const float* src = W + (size_t)(k0 + kr) * N + (c4 < 32 ? src_col0 + c4 : src_col1 + (c4 - 32));
    f32x4 v[16];
#pragma unroll
    for (int i = 0; i < 16; ++i) v[i] = *(const f32x4*)(src + (size_t)(4 * i) * N);
#pragma unroll
    for (int i = 0; i < 16; ++i) { const int kk = 4 * i + kr; f32x4 w = v[i]; if (kscale) w *= kscale[k0 + kk];
        LAS float* d = scr + kk * 65 + c4; d[0] = w[0]; d[1] = w[1]; d[2] = w[2]; d[3] = w[3]; }
    LDS_WAIT(); asm volatile("" ::: "memory");
    const int c = lane & 7;
#pragma unroll
    for (int j = 0; j < 8; ++j) { const int n = (lane >> 3) + 8 * j; const LAS float* s = scr + (8 * c) * 65 + n;
        u32x4 o; o.x = pk2(s[0 * 65], s[1 * 65]); o.y = pk2(s[2 * 65], s[3 * 65]); o.z = pk2(s[4 * 65], s[5 * 65]); o.w = pk2(s[6 * 65], s[7 * 65]);
        *(u32x4*)(WT + (size_t)(dst_row0 + n) * K + k0 + 8 * c) = o; }
    LDS_WAIT(); asm volatile("" ::: "memory");
}
__device__ __forceinline__ int win_src_col(int n) {
    const int tile = n >> 8, w = n & 255;
    if (tile >= 16 && tile < 24) { const int t = tile - 16; return w < 128 ? 4096 + 128 * t + w : 6144 + 128 * t + (w - 128); }
    if (tile >= 24 && tile < 32) { const int t = tile - 24; return w < 128 ? 5120 + 128 * t + w : 7168 + 128 * t + (w - 128); }
    return n;
}
__device__ __forceinline__ void rms_row_to_bf16(const float* xrow, const float* g, bf16* orow, int lane) {
    const f32x4* xr = (const f32x4*)xrow + lane; const f32x4* gr = (const f32x4*)g + lane;
    f32x4 v[4]; float s = 0.f;
#pragma unroll
    for (int j = 0; j < 4; ++j) { v[j] = xr[64 * j]; s += (v[j][0] * v[j][0] + v[j][1] * v[j][1]) + (v[j][2] * v[j][2] + v[j][3] * v[j][3]); }
    const float rstd = 1.0f / sqrtf(wave_sum(s) * (1.f / D) + EPS);
    u32x2* o8 = (u32x2*)orow + lane;
#pragma unroll
    for (int j = 0; j < 4; ++j) { const f32x4 gg = gr[64 * j]; const f32x4 y = v[j] * rstd * gg; u32x2 w; w.x = pk2(y[0], y[1]); w.y = pk2(y[2], y[3]); o8[64 * j] = w; }
}
__device__ __forceinline__ void sincos_d(double a, float& s, float& c) {
    const double TWO_OVER_PI = 0.63661977236758134308, PIO2_HI = 1.57079632679489655800e+00, PIO2_LO = 6.12323399573676603587e-17;
    const double q = rint(a * TWO_OVER_PI); double t = fma(-q, PIO2_HI, a); t = fma(-q, PIO2_LO, t);
    const double t2 = t * t;
    double sp = -1.0 / 1307674368000.0; sp = fma(sp, t2, 1.0 / 6227020800.0); sp = fma(sp, t2, -1.0 / 39916800.0); sp = fma(sp, t2, 1.0 / 362880.0); sp = fma(sp, t2, -1.0 / 5040.0); sp = fma(sp, t2, 1.0 / 120.0); sp = fma(sp, t2, -1.0 / 6.0); sp = fma(sp * t2, t, t);
    double cp = 1.0 / 20922789888000.0; cp = fma(cp, t2, -1.0 / 87178291200.0); cp = fma(cp, t2, 1.0 / 479001600.0); cp = fma(cp, t2, -1.0 / 3628800.0); cp = fma(cp, t2, 1.0 / 40320.0); cp = fma(cp, t2, -1.0 / 720.0); cp = fma(cp, t2, 1.0 / 24.0); cp = fma(cp, t2, -0.5); cp = fma(cp, t2, 1.0);
    const int qi = (int)((long long)q & 3);
    const double sr = (qi == 0) ? sp : (qi == 1) ? cp : (qi == 2) ? -sp : -cp;
    const double cr = (qi == 0) ? cp : (qi == 1) ? -sp : (qi == 2) ? -cp : sp;
    s = (float)sr; c = (float)cr;
}
__device__ __forceinline__ void p0_prologue(const Bufs& b, LAS unsigned char* lds, int vcu, int G, int wave, int lane, int tid) {
    LAS float* scr = (LAS float*)(lds + wave * 17408);
    const int gw = vcu * NWAVES + wave, NGW = G * NWAVES;
    constexpr int I_IN = 16 * (NIN / 64), I_SQ = 16 * 16, I_KV = 16 * 32, NITEMS = I_IN + 4 * I_SQ + I_KV;
    for (int it = gw; it < NITEMS; it += NGW) {
        int r = it;
        if (r < I_IN) { const int nb = r >> 4, kb = r & 15; p0_transpose_item(b.w_in(), D, NIN, b.Win(), win_src_col(nb * 64), win_src_col(nb * 64 + 32), nb * 64, kb * 64, scr, lane); continue; } r -= I_IN;
        if (r < 4 * I_SQ) { const int wsel = r / I_SQ, q = r % I_SQ, nb = q >> 4, kb = q & 15;
            const float* W = wsel == 0 ? b.w_ro() : wsel == 1 ? b.w_co() : wsel == 2 ? b.w_mo() : b.w_out(); bf16* WT = wsel == 0 ? b.Wro() : wsel == 1 ? b.Wco() : wsel == 2 ? b.Wmo() : b.Wout();
            p0_transpose_item(W, D, D, WT, nb * 64, nb * 64 + 32, nb * 64, kb * 64, scr, lane, wsel == 0 ? b.ret_g() : nullptr); continue; }
        r -= 4 * I_SQ;
        { const int nb = r >> 4, kb = r & 15; p0_transpose_item(b.w_mkv(), D, 2 * D, b.Wmkv(), nb * 64, nb * 64 + 32, nb * 64, kb * 64, scr, lane); }
    }
    for (int m = gw; m < MT; m += NGW) rms_row_to_bf16(m < MP ? b.xp() + (size_t)m * D : b.xs() + (size_t)(m - MP) * D, b.norm_g(), b.H() + (size_t)m * D, lane);
    for (int m = gw; m < NB * 256; m += NGW) rms_row_to_bf16(b.memp() + (size_t)m * D, b.memn_g(), b.MN() + (size_t)m * D, lane);
    for (int e = vcu * 512 + tid; e < NPOS * 128; e += G * 512) {
        const int p = e >> 7, j = e & 127; const double pos = p < SEQ ? (double)p : (double)(16384 + (p - SEQ));
        double inv = 1.0, bs = 0.93057204092969897916;
#pragma unroll
        for (int k = 0; k < 7; ++k) { if ((j >> k) & 1) inv *= bs; bs *= bs; }
        float s, c; sincos_d(pos * inv, s, c); b.cosT()[e] = c; b.sinT()[e] = s;
    }
}

__device__ __forceinline__ void ret_sample_unit(Bufs b, LAS unsigned char* lds, int bb, int h, int tid, int wave, int lane, int dry) {
    asm volatile("" : "+s"(b.ka));
    asm volatile("" : "+v"(tid), "+v"(lane));
    LAS float* qk = (LAS float*)lds;
    LAS float* red = (LAS float*)(lds + 16384);
    LAS float* Ap = (LAS float*)(lds + 16384 + 65536);
    const float ch = b.clg(h);
    const int r0 = MP + bb * DECS;
    const size_t sbase = (size_t)(bb * 4 + h) * 65536;
    int wrow = wave * 32; asm volatile("" : "+v"(wrow));
    const float* sin_ = b.state_ret() + sbase + 4 * lane + (size_t)wrow * 256; float* sout = b.out + O_RS + sbase + 4 * lane + (size_t)wrow * 256;
    f32x4 sA[8], sB[8];
#define RS_LOAD(buf, dd) do { _Pragma("unroll") for (int k = 0; k < 8; ++k) buf[k] = *(const f32x4*)(sin_ + (size_t)((dd) + k) * 256); } while (0)
    RS_LOAD(sA, 0);
    {
        const int row = tid & 15, dch = tid >> 4; const bf16* src = (row < 8 ? b.Q() : b.KT()) + (size_t)(r0 + (row & 7)) * D + h * 256 + dch * 8;
        f32x4 a0, a1; unpack8(*(const u32x4*)src, a0, a1); float sc = 1.f;
        if (row >= 8) sc = __builtin_amdgcn_exp2f(-(float)(7 - (row & 7)) * ch);
#pragma unroll
        for (int e = 0; e < 4; ++e) { qk[(dch * 8 + e) * 16 + row] = a0[e] * sc; qk[(dch * 8 + 4 + e) * 16 + row] = a1[e] * sc; }
    }
    f32x4 vv[8];
#pragma unroll
    for (int j = 0; j < 8; ++j) { const u32x2 w = *(const u32x2*)(b.Vs() + (size_t)(bb * DECS + j) * D + h * 256 + 4 * lane); vv[j] = (f32x4){bflo(w.x), bfhi(w.x), bflo(w.y), bfhi(w.y)}; }
    LDS_WAIT(); __syncthreads();
    f32x4 oacc[8];
#pragma unroll
    for (int i = 0; i < 8; ++i) oacc[i] = (f32x4){0.f, 0.f, 0.f, 0.f};
    const float g8 = __builtin_amdgcn_exp2f(-8.0f * ch);
#define RS_COMP(buf, dd) do { _Pragma("unroll") for (int k = 0; k < 8; ++k) { const int d = wave * 32 + (dd) + k; \
            const LAS f32x4* qr = (const LAS f32x4*)(qk + d * 16); const f32x4 q0 = qr[0], q1 = qr[1], k0 = qr[2], k1 = qr[3]; \
            f32x4 sn = buf[k] * g8; \
            _Pragma("unroll") for (int i = 0; i < 4; ++i) { oacc[i] += buf[k] * q0[i]; oacc[4 + i] += buf[k] * q1[i]; sn += vv[i] * k0[i]; sn += vv[4 + i] * k1[i]; } \
            if (!dry) *(f32x4*)(sout + (size_t)((dd) + k) * 256) = sn; } } while (0)
    RS_LOAD(sB, 8); RS_COMP(sA, 0); RS_LOAD(sA, 16); RS_COMP(sB, 8); RS_LOAD(sB, 24); RS_COMP(sA, 16); RS_COMP(sB, 24);
#undef RS_LOAD
#undef RS_COMP
#pragma unroll
    for (int i = 0; i < 8; ++i) *(LAS f32x4*)(red + (wave * 8 + i) * 256 + 4 * lane) = oacc[i];
    {
        const int i = lane >> 3, j = lane & 7; float s = 0.f;
#pragma unroll 8
        for (int d = wave * 32; d < wave * 32 + 32; ++d) s += qk[d * 16 + i] * qk[d * 16 + 8 + j];
        Ap[wave * 64 + lane] = s;
    }
    LDS_WAIT(); __syncthreads();
    {
        const int i = wave; f32x4 o = (f32x4){0.f, 0.f, 0.f, 0.f};
#pragma unroll
        for (int w = 0; w < 8; ++w) o += *(const LAS f32x4*)(red + (w * 8 + i) * 256 + 4 * lane);
        o *= __builtin_amdgcn_exp2f(-(float)(i + 1) * ch);
        const float gi7 = __builtin_amdgcn_exp2f((float)(7 - i) * ch);
#pragma unroll
        for (int j = 0; j < 8; ++j) { if (j <= i) { float a = 0.f;
#pragma unroll
                for (int w = 0; w < 8; ++w) a += Ap[w * 64 + i * 8 + j];
                o += vv[j] * (a * gi7); } }
        const float ss = wave_sum((o[0] * o[0] + o[1] * o[1]) + (o[2] * o[2] + o[3] * o[3]));
        const float rstd = 1.0f / sqrtf(ss * (1.0f / 256.0f) + EPS);
        const size_t ro = (size_t)(r0 + i) * D + h * 256 + 4 * lane;
        const u32x2 rw = *(const u32x2*)(b.RG() + ro); const f32x4 rg = (f32x4){bflo(rw.x), bfhi(rw.x), bflo(rw.y), bfhi(rw.y)};
        const f32x4 y = o * rstd * rg; u32x2 w; w.x = pk2(y[0], y[1]); w.y = pk2(y[2], y[3]);
        if (!dry) *(u32x2*)(b.Q() + ro) = w;
    }
    LDS_WAIT(); __syncthreads();
}
__device__ __forceinline__ void xattn_sample_unit(Bufs b, LAS unsigned char* lds, int bb, int h, int tid, int wave, int lane, int dry) {
    asm volatile("" : "+s"(b.ka));
    asm volatile("" : "+v"(tid), "+v"(lane));
    LAS float* sc = (LAS float*)lds;
    LAS float* pT = (LAS float*)(lds + 8192);
    LAS float* red = (LAS float*)(lds + 16384);
    const int r0 = MP + bb * DECS; const int fr = lane & 15, fq = lane >> 4;
    int wrow = wave * 32; asm volatile("" : "+v"(wrow));
    const float* vp = b.cmv() + ((size_t)(bb * 256) * 4 + h) * 256 + 4 * lane + (size_t)wrow * 1024;
    f32x4 vA[8], vB[8];
#define XV_LOAD(buf, mm) do { _Pragma("unroll") for (int k = 0; k < 8; ++k) buf[k] = *(const f32x4*)(vp + (size_t)((mm) + k) * 1024); } while (0)
    XV_LOAD(vA, 0);
    bf16x8 bq[8];
#pragma unroll
    for (int kk = 0; kk < 8; ++kk) { u32x4 w = (u32x4){0u, 0u, 0u, 0u}; if (fr < 8) w = *(const u32x4*)(b.MQ() + (size_t)(r0 + fr) * D + h * 256 + 32 * kk + 8 * fq); bq[kk] = __builtin_bit_cast(bf16x8, w); }
#pragma unroll
    for (int g = 0; g < 2; ++g) {
        const int key0 = (wave * 2 + g) * 16; const float* kp = b.cmk() + ((size_t)(bb * 256 + key0 + fr) * 4 + h) * 256 + 8 * fq;
        f32x4 ka[8][2];
#pragma unroll
        for (int kk = 0; kk < 8; ++kk) { ka[kk][0] = *(const f32x4*)(kp + 32 * kk); ka[kk][1] = *(const f32x4*)(kp + 32 * kk + 4); }
        f32x4 a4 = (f32x4){0.f, 0.f, 0.f, 0.f};
#pragma unroll
        for (int kk = 0; kk < 8; ++kk) { const u32x4 w = pack8(ka[kk][0], ka[kk][1]); a4 = __builtin_amdgcn_mfma_f32_16x16x32_bf16(__builtin_bit_cast(bf16x8, w), bq[kk], a4, 0, 0, 0); }
        if (fr < 8) {
#pragma unroll
            for (int r = 0; r < 4; ++r) sc[fr * 256 + key0 + 4 * fq + r] = a4[r] * (0.0625f * LOG2E);
        }
    }
    LDS_WAIT(); __syncthreads();
    {
        const int i = wave; const f32x4 s = *(const LAS f32x4*)(sc + i * 256 + 4 * lane);
        const float mx = wave_max(fmaxf(fmaxf(s[0], s[1]), fmaxf(s[2], s[3])));
        f32x4 e; float l = 0.f;
#pragma unroll
        for (int r = 0; r < 4; ++r) { e[r] = __builtin_amdgcn_exp2f(s[r] - mx); l += e[r]; }
        const float inv = 1.0f / wave_sum(l);
#pragma unroll
        for (int r = 0; r < 4; ++r) pT[(4 * lane + r) * 8 + i] = e[r] * inv;
    }
    LDS_WAIT(); __syncthreads();
    f32x4 oacc[8];
#pragma unroll
    for (int i = 0; i < 8; ++i) oacc[i] = (f32x4){0.f, 0.f, 0.f, 0.f};
#define XV_COMP(buf, mm) do { _Pragma("unroll") for (int k = 0; k < 8; ++k) { const LAS f32x4* pr = (const LAS f32x4*)(pT + (wave * 32 + (mm) + k) * 8); const f32x4 p0 = pr[0], p1 = pr[1]; \
            _Pragma("unroll") for (int i = 0; i < 4; ++i) { oacc[i] += buf[k] * p0[i]; oacc[4 + i] += buf[k] * p1[i]; } } } while (0)
    XV_LOAD(vB, 8); XV_COMP(vA, 0); XV_LOAD(vA, 16); XV_COMP(vB, 8); XV_LOAD(vB, 24); XV_COMP(vA, 16); XV_COMP(vB, 24);
#undef XV_LOAD
#undef XV_COMP
#pragma unroll
    for (int i = 0; i < 8; ++i) *(LAS f32x4*)(red + (wave * 8 + i) * 256 + 4 * lane) = oacc[i];
    LDS_WAIT(); __syncthreads();
    {
        const int i = wave; f32x4 o = (f32x4){0.f, 0.f, 0.f, 0.f};
#pragma unroll
        for (int w = 0; w < 8; ++w) o += *(const LAS f32x4*)(red + (w * 8 + i) * 256 + 4 * lane);
        const size_t ro = (size_t)(r0 + i) * D + h * 256 + 4 * lane;
        const u32x2 gw = *(const u32x2*)(b.MG() + ro); const f32x4 y = o * (f32x4){bflo(gw.x), bfhi(gw.x), bflo(gw.y), bfhi(gw.y)};
        u32x2 w; w.x = pk2(y[0], y[1]); w.y = pk2(y[2], y[3]);
        LDS_WAIT(); __syncthreads();
        if (!dry) *(u32x2*)(b.MQ() + ro) = w;
    }
}
__device__ __forceinline__ void conv_chunk(Bufs b, int chunk, int tid, int dry) {
    asm volatile("" : "+s"(b.ka));
    asm volatile("" : "+v"(tid));
    const int task = chunk * 512 + tid; constexpr int NPT = (MP / 16) * 128;
    int r0, nrows, t0; const float* st = nullptr;
    const int cg = task & 127, c0 = cg * 8;
    if (task < NPT) { const int run = task >> 7; r0 = run * 16; nrows = 16; t0 = r0 & (SEQ - 1); }
    else { const int run = (task - NPT) >> 7; r0 = MP + run * 8; nrows = 8; t0 = 0; st = b.state_conv() + (size_t)run * 2 * D + c0; }
    f32x4 w0a = *(const f32x4*)(b.conv_w() + c0), w0b = *(const f32x4*)(b.conv_w() + c0 + 4), w1a = *(const f32x4*)(b.conv_w() + D + c0), w1b = *(const f32x4*)(b.conv_w() + D + c0 + 4),
          w2a = *(const f32x4*)(b.conv_w() + 2 * D + c0), w2b = *(const f32x4*)(b.conv_w() + 2 * D + c0 + 4), ba = *(const f32x4*)(b.conv_b() + c0), bb_ = *(const f32x4*)(b.conv_b() + c0 + 4);
    f32x4 xm2a, xm2b, xm1a, xm1b;
    const f32x4 z = (f32x4){0.f, 0.f, 0.f, 0.f};
    if (t0 >= 2) { unpack8(*(const u32x4*)(b.PRE() + (size_t)(r0 - 2) * D + c0), xm2a, xm2b); unpack8(*(const u32x4*)(b.PRE() + (size_t)(r0 - 1) * D + c0), xm1a, xm1b); }
    else if (st) { xm2a = *(const f32x4*)st; xm2b = *(const f32x4*)(st + 4); xm1a = *(const f32x4*)(st + D); xm1b = *(const f32x4*)(st + D + 4); }
    else { xm2a = z; xm2b = z; xm1a = z; xm1b = z; }
#pragma unroll 4
    for (int k = 0; k < nrows; ++k) {
        const size_t ro = (size_t)(r0 + k) * D + c0;
        f32x4 xa, xb, ga, gb; unpack8(*(const u32x4*)(b.PRE() + ro), xa, xb); unpack8(*(const u32x4*)(b.GCB() + ro), ga, gb);
        const f32x4 ya = ga * (ba + w0a * xm2a + w1a * xm1a + w2a * xa), yb = gb * (bb_ + w0b * xm2b + w1b * xm1b + w2b * xb);
        if (!dry) *(u32x4*)(b.GCB() + ro) = pack8(ya, yb);
        xm2a = xm1a; xm2b = xm1b; xm1a = xa; xm1b = xb;
    }
}
constexpr int NSTREAM_RET = DECB * 4, NSTREAM_X = DECB * 4, NSTREAM_CONV = ((MP / 16) * 128 + DECB * 128) / 512;

__global__ void __launch_bounds__(NWAVES * 64, 2) fwd_kernel(Params p) {
    extern __shared__ __attribute__((aligned(16))) unsigned char lds_[];
    LAS unsigned char* lds = (LAS unsigned char*)lds_;
    volatile LAS unsigned* MISC = (volatile LAS unsigned*)(lds + LDS_MISC);
    const int wave = __builtin_amdgcn_readfirstlane((int)threadIdx.x >> 6);
#define LANE_ID() ((int)__builtin_amdgcn_mbcnt_hi(~0u, __builtin_amdgcn_mbcnt_lo(~0u, 0u)))
#define TID() (wave * 64 + LANE_ID())
    const int G = gridDim.x, bx = blockIdx.x, vcu = (G % 8 == 0) ? (bx % 8) * (G / 8) + bx / 8 : bx;
    Bufs b; b.ka = (kargp_t)__builtin_amdgcn_kernarg_segment_ptr(); b.ws = p.ws; b.out = p.out;
    if (wave == 0) MISC[LANE_ID()] = 0u;
    __syncthreads();
    if (bx == 0) { u32x4* z = (u32x4*)(b.ctl() + 4096) + TID();
#pragma unroll
        for (int k = 0; k < 4; ++k) z[512 * k] = (u32x4){0u, 0u, 0u, 0u};
        asm volatile("s_waitcnt vmcnt(0)" ::: "memory"); __syncthreads();
        if (wave == 0) { __builtin_amdgcn_fence(__ATOMIC_RELEASE, "agent"); asm volatile("s_waitcnt vmcnt(0)" ::: "memory"); __hip_atomic_store(b.ctl() + CW_READY, 1u, __ATOMIC_RELAXED, __HIP_MEMORY_SCOPE_AGENT); } }
    XcdBarrier bar; bar.bar = b.ctl() + CW_BAR; bar.x = xb_xcc_id(); bar.st = MISC + 8;

    const int lo = p.ph_lo, hi = p.ph_hi;
#ifndef PHMASK
#define PHMASK 0x7f
#endif
#define IN(k) (((PHMASK >> (k)) & 1) && lo <= (k) && (k) < hi)
#define SEAM(k) do { if (IN(k) && IN((k) + 1)) xcd_barrier(bar, (k) == 0 ? b.ctl() + CW_READY : nullptr); } while (0)
    constexpr int PROBE = PROBE_PHASE;
#define GEMM_PHASE(k, DRY) GEMM_PHASE_W(k, DRY, 0, 1 << 30)
#define GEMM_PHASE_W(k, DRY, IB, IE) do { Sched<k> S; S.G = G; S.c = bx; S.b = b; S.ibeg = (IB); S.iend = (IE); Epi<k, DRY> E; E.bufs = b; E.rt_dry = p.pad0; pg8::gemm_phase<Sched<k>, Epi<k, DRY>>(lds, S, E, wave); } while (0)
#define STREAM_PHASE(DRY) do { unsigned* qh = b.ctl() + CW_QUEUE + ((DRY) ? 64 : 0); const int lane = LANE_ID(), tid = wave * 64 + lane; \
        for (;;) { __syncthreads(); if (tid == 0) MISC[0] = __hip_atomic_fetch_add(qh, 1u, __ATOMIC_RELAXED, __HIP_MEMORY_SCOPE_AGENT); __syncthreads(); \
            const int item = (int)MISC[0]; if (item >= (MP / 16) * 128 / 512) break;     \
            conv_chunk(b, item, tid, (DRY) ? p.pad0 : 0); } } while (0)
    if (PROBE == 100) { p0_prologue(b, lds, vcu, G, wave, LANE_ID(), TID()); xcd_barrier(bar); }
    if (IN(0)) p0_prologue(b, lds, vcu, G, wave, LANE_ID(), TID());
    SEAM(0);
    if (PROBE == 101) { GEMM_PHASE(1, false); xcd_barrier(bar); }
    if (PROBE == 1) { GEMM_PHASE(1, true); xcd_barrier(bar); }
    if (IN(1)) {
        const int ksplit = 2 + ((bx >> 3) + 4 * (bx & 7)) % 11;
        GEMM_PHASE_W(1, false, 0, ksplit);
        { unsigned* sr = b.ctl() + CW_SREADY;
          if (TID() == 0) { unsigned sp = 0; while (xb_ld(sr) < 160u && ++sp < (1u << 22)) __builtin_amdgcn_s_sleep(4);
              __builtin_amdgcn_fence(__ATOMIC_ACQUIRE, "agent"); asm volatile("s_waitcnt vmcnt(0)" ::: "memory"); }
          __syncthreads();
          const int lane = LANE_ID(), tid = wave * 64 + lane;
          for (int k = 0; k < 2; ++k) { const int item = bx + 256 * k; if (item < NSTREAM_RET) ret_sample_unit(b, lds, item >> 2, item & 3, tid, wave, lane, 0); }
          for (int k = 0; k < 2; ++k) { const int item = bx + 256 * k; if (item < NSTREAM_X) xattn_sample_unit(b, lds, item >> 2, item & 3, tid, wave, lane, 0); }
          if (bx < 32) conv_chunk(b, (MP / 16) * 128 / 512 + bx, tid, 0);
          __syncthreads(); }
        GEMM_PHASE_W(1, false, ksplit, 1 << 30);
    }
    SEAM(1);
    if (PROBE == 20) { GEMM_PHASE(20, true); GEMM_PHASE(23, true); GEMM_PHASE(21, true); GEMM_PHASE(22, true); xcd_barrier(bar); }
    if (PROBE == 21) { STREAM_PHASE(1); xcd_barrier(bar); }
    if (IN(2)) {
        GEMM_PHASE(20, false);
        if (bx >= 32 && bx < 80) {
            GEMM_PHASE(24, false);
            if (bx < 48) {
                unsigned* sc = b.ctl() + CW_SCNT + 16 * ((bx - 32) >> 2);
                if (TID() == 0) { unsigned sp = 0; while (xb_ld(sc) < 4u && ++sp < (1u << 22)) __builtin_amdgcn_s_sleep(4);
                    __builtin_amdgcn_fence(__ATOMIC_ACQUIRE, "agent"); asm volatile("s_waitcnt vmcnt(0)" ::: "memory"); }
                __syncthreads();
                GEMM_PHASE(52, false);
            }
        }
        if (bx >= 48) {
            GEMM_PHASE(23, false);
            unsigned* mkd = b.ctl() + CW_MKDONE;
            if (bx >= 80 && bx < 144 && TID() == 0) { __builtin_amdgcn_fence(__ATOMIC_RELEASE, "agent"); asm volatile("s_waitcnt vmcnt(0)" ::: "memory"); (void)xb_add(mkd, 1u); }
            GEMM_PHASE(21, false);
            if (bx >= 144 || bx < 80) {
            {
                unsigned* qh = b.ctl() + CW_QUEUE; const int lane = LANE_ID(), tid = wave * 64 + lane;
                for (;;) { __syncthreads();
                    if (tid == 0) { const unsigned done = xb_ld(mkd) >= 64u ? 1u : 0u; MISC[1] = done; MISC[0] = done ? 0u : __hip_atomic_fetch_add(qh, 1u, __ATOMIC_RELAXED, __HIP_MEMORY_SCOPE_AGENT); }
                    __syncthreads();
                    if (MISC[1]) break;
                    const int item = (int)MISC[0];
                    if (item >= (MP / 16) * 128 / 512) { if (tid == 0) { unsigned sp = 0; while (xb_ld(mkd) < 64u && ++sp < (1u << 22)) __builtin_amdgcn_s_sleep(4); } break; }
                    conv_chunk(b, item, tid, 0); }
                if (tid == 0) { __builtin_amdgcn_fence(__ATOMIC_ACQUIRE, "agent"); asm volatile("s_waitcnt vmcnt(0)" ::: "memory"); }
                __syncthreads(); }
            GEMM_PHASE(22, false);
            __builtin_amdgcn_fence(__ATOMIC_ACQUIRE, "agent"); __syncthreads();
            GEMM_PHASE(31, false);
            }
        }
        STREAM_PHASE(0);
    }
    SEAM(2);
    if (PROBE == 3) { GEMM_PHASE(30, true); GEMM_PHASE(31, true); xcd_barrier(bar); }
    if (IN(3)) GEMM_PHASE(30, false);
    SEAM(3);
    if (PROBE == 4) { GEMM_PHASE(4, true); xcd_barrier(bar); }
    if (IN(4)) GEMM_PHASE(4, false);
    SEAM(4);
    if (PROBE == 5) { GEMM_PHASE(5, true); xcd_barrier(bar); }
    if (IN(5)) GEMM_PHASE(5, false);
    if (bx == 0 && wave == 0) __hip_atomic_store(b.ctl() + CW_READY, 0u, __ATOMIC_RELAXED, __HIP_MEMORY_SCOPE_AGENT);
#undef IN
#undef SEAM
#undef GEMM_PHASE
#undef GEMM_PHASE_W
#undef STREAM_PHASE
#undef LANE_ID
#undef TID
}

#ifndef MK_N_LAUNCHES
#define MK_N_LAUNCHES 1
#endif
extern "C" void kernel_launch(void* const* d_in, const int* in_sizes, int n_in, void* d_out, int out_size, void* d_ws, size_t ws_size, hipStream_t stream) {
    static int grid = 0;
    if (grid == 0) {
        if (n_in != 20 || (size_t)out_size != O_END || ws_size < WS_END) { fprintf(stderr, "kernel_launch: unexpected shapes (n_in %d, out %d, ws %zu); nothing launched\n", n_in, out_size, ws_size); grid = -1; return; }
        int dev = 0, cus = 0, per_cu = 0;
        if (hipGetDevice(&dev) != hipSuccess || hipDeviceGetAttribute(&cus, hipDeviceAttributeMultiprocessorCount, dev) != hipSuccess) { grid = -1; return; }
        if (hipFuncSetAttribute((const void*)fwd_kernel, hipFuncAttributeMaxDynamicSharedMemorySize, LDS_BYTES) != hipSuccess) { fprintf(stderr, "kernel_launch: hipFuncSetAttribute failed\n"); grid = -1; return; }
        if (hipOccupancyMaxActiveBlocksPerMultiprocessor(&per_cu, (const void*)fwd_kernel, NWAVES * 64, LDS_BYTES) != hipSuccess || per_cu < 1) { fprintf(stderr, "kernel_launch: occupancy query says %d blocks per CU\n", per_cu); (void)hipGetLastError(); grid = -1; return; }
        grid = cus;
        if (grid != 256) { fprintf(stderr, "kernel_launch: built for a 256-CU device (the unit and sample-side work assignments are static in the CU index); found %d CUs; nothing launched\n", grid); grid = -1; return; }
    }
    if (grid < 0) return;
    Params p{};
    p.pad0 = (PROBE_PHASE >= 0 && PROBE_PHASE < 200) ? 1 : 0; p.pad1 = 0;
    for (int i = 0; i < 20; ++i) p.in[i] = (const float*)d_in[i];
    p.out = (float*)d_out; p.ws = (unsigned char*)d_ws;
    for (int h = 0; h < 4; ++h) { const double g = 1.0 - std::exp2(-5.0 - (double)h); p.clog[h] = (float)(-std::log2(g)); }
    if (MK_N_LAUNCHES == 1) { p.ph_lo = 0; p.ph_hi = 7; hipLaunchKernelGGL(fwd_kernel, dim3(grid), dim3(NWAVES * 64), LDS_BYTES, stream, p);
#if PROBE_PHASE >= 200
        (void)hipMemsetAsync((char*)d_ws + WS_CTL, 0, CTL_ZERO_BYTES, stream); p.ph_lo = (PROBE_PHASE >= 400) ? (PROBE_PHASE - 400) / 10 : 0; p.ph_hi = (PROBE_PHASE >= 400) ? (PROBE_PHASE - 400) % 10 + 1 : PROBE_PHASE - 200 + 1; hipLaunchKernelGGL(fwd_kernel, dim3(grid), dim3(NWAVES * 64), LDS_BYTES, stream, p);
#endif
    }
    else for (int ph = 0; ph < 7; ++ph) { p.ph_lo = ph; p.ph_hi = ph + 1; hipLaunchKernelGGL(fwd_kernel, dim3(grid), dim3(NWAVES * 64), LDS_BYTES, stream, p); }
}
```

```cpp
#include <hip/hip_runtime.h>
#include <cstdio>
#include <cstdint>
#include <cmath>
#include <cstddef>

#define LAS __attribute__((address_space(3)))
#define GAS __attribute__((address_space(1)))
typedef unsigned short bf16;
typedef short bf16x8 __attribute__((ext_vector_type(8)));
typedef float f32x4 __attribute__((ext_vector_type(4)));
typedef float f32x2 __attribute__((ext_vector_type(2)));
typedef unsigned u32x4 __attribute__((ext_vector_type(4)));
typedef unsigned u32x2 __attribute__((ext_vector_type(2)));
typedef __bf16 bf16x2_t __attribute__((ext_vector_type(2)));

constexpr int D = 1024, SEQ = 2048, NB = 8, DECB = 128, DECS = 8;
constexpr int MP = NB * SEQ;
constexpr int MS = DECB * DECS;
constexpr int MT = MP + MS;
constexpr int NIN = 13 * 1024;
constexpr int NPOS = SEQ + DECS;
constexpr float EPS = 1e-6f;
constexpr float LOG2E = 1.4426950408889634f;

constexpr size_t O_Y = 0, O_RP = (size_t)MT * D, O_RS = O_RP + (size_t)NB * 4 * 65536, O_CP = O_RS + (size_t)DECB * 4 * 65536,
                 O_CS = O_CP + (size_t)NB * 2 * D, O_MK = O_CS + (size_t)DECB * 2 * D, O_MV = O_MK + (size_t)NB * 256 * D, O_END = O_MV + (size_t)NB * 256 * D;

constexpr size_t MiB = 1u << 20;
constexpr size_t WS_CTL = 0, CTL_ZERO_BYTES = 1 * MiB;
constexpr size_t WS_GATES = 1 * MiB;
constexpr size_t WS_SALL = 103 * MiB;
constexpr size_t WS_MKB = 135 * MiB, WS_MVT = 139 * MiB;
constexpr size_t WS_Q = 143 * MiB;
constexpr size_t WS_KT = 177 * MiB;
constexpr size_t WS_KTT = 211 * MiB;
constexpr size_t WS_VT = 245 * MiB;
constexpr size_t WS_VS = 277 * MiB;
constexpr size_t WS_RG = 279 * MiB;
constexpr size_t WS_PRE = 313 * MiB;
constexpr size_t WS_GCB = 347 * MiB;
constexpr size_t WS_MQ = 381 * MiB;
constexpr size_t WS_MG = 415 * MiB;
constexpr size_t WS_GS = 449 * MiB;
constexpr size_t WS_WIN = 455 * MiB;
constexpr size_t WS_H = 481 * MiB;
constexpr size_t WS_WRO = 515 * MiB, WS_WCO = 517 * MiB, WS_WMO = 519 * MiB, WS_WOUT = 521 * MiB, WS_WMKV = 523 * MiB;
constexpr size_t WS_MN = 527 * MiB;
constexpr size_t WS_COS = 531 * MiB, WS_SIN = 532 * MiB + 512 * 1024;
constexpr size_t WS_END = 534 * MiB;

constexpr int CW_READY = 64;
constexpr int CW_BAR = 4096;
constexpr int CW_QUEUE = 8192;
constexpr int CW_MKDONE = 8192 + 128;
constexpr int CW_SREADY = 8192 + 192;
constexpr int CW_PCNT = 8192 + 256;
constexpr int CW_TCNT = 8192 + 1472;
constexpr int CW_SCNT = 8192 + 1408;
constexpr int CW_PART = 16384;

constexpr int LDS_BYTES = 163840, LDS_X = 131072, LDS_MISC = LDS_BYTES - 256;
constexpr int NWAVES = 8;
#ifndef PROBE_PHASE
#define PROBE_PHASE -1
#endif

__device__ __forceinline__ unsigned pk2(float lo, float hi) { f32x2 v = {lo, hi}; bf16x2_t b = __builtin_convertvector(v, bf16x2_t); return __builtin_bit_cast(unsigned, b); }
__device__ __forceinline__ float bflo(unsigned w) { return __uint_as_float(w << 16); }
__device__ __forceinline__ float bfhi(unsigned w) { return __uint_as_float(w & 0xffff0000u); }
__device__ __forceinline__ u32x4 pack8(f32x4 a, f32x4 b) { u32x4 w; w.x = pk2(a[0], a[1]); w.y = pk2(a[2], a[3]); w.z = pk2(b[0], b[1]); w.w = pk2(b[2], b[3]); return w; }
__device__ __forceinline__ void unpack8(u32x4 w, f32x4& a, f32x4& b) { a = (f32x4){bflo(w.x), bfhi(w.x), bflo(w.y), bfhi(w.y)}; b = (f32x4){bflo(w.z), bfhi(w.z), bflo(w.w), bfhi(w.w)}; }
__device__ __forceinline__ float sigm(float x) { return __builtin_amdgcn_rcpf(1.0f + __builtin_amdgcn_exp2f(-LOG2E * x)); }
__device__ __forceinline__ f32x4 sigm4(f32x4 x) { return (f32x4){sigm(x[0]), sigm(x[1]), sigm(x[2]), sigm(x[3])}; }
__device__ __forceinline__ f32x4 silu4(f32x4 x) { return x * sigm4(x); }
__device__ __forceinline__ float wave_sum(float v) {
#pragma unroll
    for (int o = 1; o < 64; o <<= 1) v += __shfl_xor(v, o);
    return v;
}
__device__ __forceinline__ float wave_max(float v) {
#pragma unroll
    for (int o = 1; o < 64; o <<= 1) v = fmaxf(v, __shfl_xor(v, o));
    return v;
}
#define LDS_WAIT() asm volatile("s_waitcnt lgkmcnt(0)" ::: "memory")
#define VM_WAIT() asm volatile("s_waitcnt vmcnt(0)" ::: "memory")

struct Params {
    const float* in[20]; float* out; unsigned char* ws;
    float clog[4];
    int ph_lo, ph_hi;
    int pad0, pad1;
};
static_assert(sizeof(Params) == 208 && offsetof(Params, clog) == 176, "Params layout (the kernel reads it through the kernarg segment pointer)");
typedef const __attribute__((address_space(4))) unsigned long long* kargp_t;
struct Bufs {
    kargp_t ka; unsigned char* ws; float* out;
    __device__ __forceinline__ const float* in(int i) const { return (const float*)ka[i]; }
    __device__ __forceinline__ float clg(int h) const { return __builtin_bit_cast(f32x2, ka[22 + (h >> 1)])[h & 1]; }
#define BUF_IN(name, i) __device__ __forceinline__ const float* name() const { return in(i); }
    BUF_IN(xp, 0) BUF_IN(xs, 1) BUF_IN(state_ret, 2) BUF_IN(state_conv, 3) BUF_IN(cmk, 4) BUF_IN(cmv, 5) BUF_IN(memp, 6) BUF_IN(norm_g, 7) BUF_IN(w_in, 8) BUF_IN(b_gate, 9)
    BUF_IN(ret_g, 10) BUF_IN(conv_w, 11) BUF_IN(conv_b, 12) BUF_IN(w_ro, 13) BUF_IN(w_co, 14) BUF_IN(w_mo, 15) BUF_IN(w_out, 16) BUF_IN(memn_g, 17) BUF_IN(w_mkv, 18) BUF_IN(fin_g, 19)
#undef BUF_IN
#define BUF_WS(T, name, off) __device__ __forceinline__ T* name() const { return (T*)(ws + (off)); }
    BUF_WS(unsigned, ctl, WS_CTL) BUF_WS(float, cosT, WS_COS) BUF_WS(float, sinT, WS_SIN)
    BUF_WS(bf16, Wro, WS_WRO) BUF_WS(bf16, Wco, WS_WCO) BUF_WS(bf16, Wmo, WS_WMO) BUF_WS(bf16, Wout, WS_WOUT) BUF_WS(bf16, Wmkv, WS_WMKV) BUF_WS(bf16, Win, WS_WIN)
    BUF_WS(bf16, MN, WS_MN) BUF_WS(bf16, MKb, WS_MKB) BUF_WS(bf16, MVt, WS_MVT) BUF_WS(bf16, H, WS_H) BUF_WS(bf16, Q, WS_Q) BUF_WS(bf16, KT, WS_KT) BUF_WS(bf16, KTt, WS_KTT)
    BUF_WS(bf16, Vt, WS_VT) BUF_WS(bf16, Vs, WS_VS) BUF_WS(bf16, RG, WS_RG) BUF_WS(bf16, PRE, WS_PRE) BUF_WS(bf16, GCB, WS_GCB) BUF_WS(bf16, MQ, WS_MQ) BUF_WS(bf16, MG, WS_MG)
    BUF_WS(bf16, GATES, WS_GATES) BUF_WS(bf16, SALL, WS_SALL) BUF_WS(bf16, GS, WS_GS) BUF_WS(float, YS, WS_Q)
    __device__ __forceinline__ bf16* smerged(int pn) const { return (bf16*)(ws + (pn == 0 ? WS_H + (size_t)MP * D * 2 : pn == 1 ? WS_KT + (size_t)MP * D * 2 : pn == 2 ? WS_PRE + (size_t)MP * D * 2 : WS_VS)); }
#undef BUF_WS
};

namespace pg8 {
constexpr int BM = 256, BK = 64, HALF = 128, HTB = HALF * BK * 2, STAGE_BYTES = 8 * HTB;
__host__ __device__ __forceinline__ int lds_byte(int r, int c) { const int st = (r >> 4) * 2 + (c >> 5), rr = r & 15, cc = c & 31, ob = rr * 64 + cc * 2; return st * 1024 + (ob ^ (((ob >> 9) & 1) << 5)); }
__host__ __device__ __forceinline__ void stage_rc(int b, int& R, int& C) { const int st = b / 1024, sb = b % 1024, swz = sb ^ (((sb >> 9) & 1) << 5); R = (st >> 1) * 16 + swz / 64; C = (st & 1) * 32 + (swz % 64) / 2; }
__host__ __device__ __forceinline__ int perm32(int rho) { const int n = rho >> 4, i = rho & 15; return 8 * (i >> 2) + 4 * n + (i & 3); }

enum Kind { K_RQ = 0, K_RK, K_RV, K_RVT, K_RG, K_CA, K_CB, K_MQ, K_MG, K_GL, K_MK, K_MVT, K_QK, K_CHAIN, K_XS, K_RETO, K_XO, K_P3A, K_P3B, K_P3S };
struct Unit {
    const char* A; const char* B;
    unsigned lda, ldb;
    unsigned meta;
    unsigned pmn;
    __device__ __forceinline__ int kind() const { return (int)(meta & 31u); }
    __device__ __forceinline__ int aux() const { return (int)((meta >> 6) & 3u); }
    __device__ __forceinline__ int nt() const { return (int)((meta >> 8) & 255u); }
    __device__ __forceinline__ bool keep() const { return (meta & 32u) != 0u; }
    __device__ __forceinline__ int pm() const { return (int)(pmn & 0xffffu); }
    __device__ __forceinline__ int pn() const { return (int)(pmn >> 16); }
    __device__ __forceinline__ void set(int kind, int pm, int pn, int nt = 16, int aux = 0, int keep = 0) { meta = (unsigned)kind | ((unsigned)keep << 5) | ((unsigned)aux << 6) | ((unsigned)nt << 8); pmn = (unsigned)pm | ((unsigned)pn << 16); }
};

template <class Sched, class Epi>
__device__ __forceinline__ void gemm_phase(LAS unsigned char* lds, const Sched& S, const Epi& E, int wid) {
    int lane = (int)__builtin_amdgcn_mbcnt_hi(~0u, __builtin_amdgcn_mbcnt_lo(~0u, 0u)); asm volatile("" : "+v"(lane));
    const int tid = wid * 64 + lane, wr = wid >> 2, wc = wid & 3, fr = lane & 15, fq = lane >> 4;
    unsigned Ra0, Rb0, Cc0;
    { int R, C; stage_rc(tid * 16, R, C); Ra0 = (unsigned)R; Rb0 = (unsigned)((R & ~31) + perm32(R & 31)); Cc0 = (unsigned)C * 2u; }
    const unsigned ldsw = (unsigned)wid * 1024u;
    const int aoff = lds_byte(wr * 64 + fr, fq * 8), boff = lds_byte(wc * 32 + fr, fq * 8);
#define PG8_SA(b, h) (((b) * 2 + (h)) * HTB)
#define PG8_SB(b, h) ((4 + (b) * 2 + (h)) * HTB)
#define PG8_STAGE(bufoff, gbase, R0, ld) do { const unsigned _v = (R0) * (ld) + Cc0; const char* _g = (const char*)(gbase); \
        __builtin_amdgcn_global_load_lds((const unsigned*)(_g + _v), (LAS unsigned*)(lds + (bufoff) + ldsw), 16, 0, 0); \
        __builtin_amdgcn_global_load_lds((const unsigned*)(_g + 64u * (ld) + _v), (LAS unsigned*)(lds + (bufoff) + ldsw + 8192), 16, 0, 0); } while (0)
#define PG8_STA(bufoff, gbase, ld) PG8_STAGE(bufoff, gbase, Ra0, ld)
#define PG8_STB(bufoff, gbase, ld) PG8_STAGE(bufoff, gbase, Rb0, ld)
#define PG8_LDA(dst, b, h) do { _Pragma("unroll") for (int m = 0; m < 4; ++m) _Pragma("unroll") for (int k = 0; k < 2; ++k) dst[m][k] = *(const LAS bf16x8*)(lds + PG8_SA(b, h) + aoff + m * 2048 + k * 1024); } while (0)
#define PG8_LDB(dst, b, h) do { _Pragma("unroll") for (int n = 0; n < 2; ++n) _Pragma("unroll") for (int k = 0; k < 2; ++k) dst[n][k] = *(const LAS bf16x8*)(lds + PG8_SB(b, h) + boff + n * 2048 + k * 1024); } while (0)
#define PG8_MMA(ai, bj, At, Bt) do { __builtin_amdgcn_s_setprio(1); _Pragma("unroll") for (int m = 0; m < 4; ++m) _Pragma("unroll") for (int n = 0; n < 2; ++n) _Pragma("unroll") for (int k = 0; k < 2; ++k) \
        acc[ai][bj][m][n] = __builtin_amdgcn_mfma_f32_16x16x32_bf16(Bt[n][k], At[m][k], acc[ai][bj][m][n], 0, 0, 0); __builtin_amdgcn_s_setprio(0); } while (0)
#define PG8_WAIT_V(n) asm volatile("s_waitcnt vmcnt(" #n ")" ::: "memory")
#define PG8_WAIT_L(n) asm volatile("s_waitcnt lgkmcnt(" #n ")" ::: "memory")
#define PG8_BAR __builtin_amdgcn_s_barrier()
#define PG8_SCHED __builtin_amdgcn_sched_barrier(0)
#define PG8_PA(u, tt) ((u).A + (unsigned)(tt) * 128u + (((tt) >= 4 && (u).kind() == K_RETO) ? (long long)(WS_Q - WS_H) - 512 : 0ll))
#define PG8_PB(u, tt) ((u).B + (unsigned)(tt) * 128u + (((tt) >= 4 && (u).kind() == K_RETO) ? (long long)(WS_SALL - WS_VT) - 512 : 0ll))
    Unit cur; int ui = 0;
    if (!S.next(0, cur)) return;
    { const unsigned dl = S.start_delay();
      if (dl) { const unsigned long long t0 = __builtin_amdgcn_s_memrealtime(); while (__builtin_amdgcn_s_memrealtime() - t0 < dl) __builtin_amdgcn_s_sleep(8); } }
    f32x4 acc[2][2][4][2];
#pragma unroll
    for (int a = 0; a < 2; ++a)
#pragma unroll
        for (int b = 0; b < 2; ++b)
#pragma unroll
            for (int m = 0; m < 4; ++m)
#pragma unroll
                for (int n = 0; n < 2; ++n) acc[a][b][m][n] = (f32x4){0.f, 0.f, 0.f, 0.f};
    bf16x8 At[4][2], B0[2][2], B1[2][2];
    {
        const char* cA = cur.A; const char* cB = cur.B; const unsigned la = cur.lda, lb = cur.ldb;
        PG8_STB(PG8_SB(0, 0), cB, lb); PG8_STB(PG8_SB(0, 1), cB + 128u * lb, lb); PG8_STA(PG8_SA(0, 0), cA, la); PG8_STA(PG8_SA(0, 1), cA + 128u * la, la);
        PG8_STB(PG8_SB(1, 0), cB + 128, lb); PG8_STB(PG8_SB(1, 1), cB + 128u * lb + 128, lb); PG8_STA(PG8_SA(1, 0), cA + 128, la); PG8_STA(PG8_SA(1, 1), cA + 128u * la + 128, la);
        if (wr == 1) PG8_BAR;
        PG8_WAIT_V(0); PG8_BAR; PG8_BAR;
    }
#define PG8_BODY(T, REL) do { const int t = (T); const bool last = (REL) ? false : (t == nt - 2); \
            const unsigned la2 = last ? nla : cla, lb2 = last ? nlb : clb; \
              \
            PG8_LDB(B0, 0, 0); PG8_LDB(B1, 0, 1); PG8_SCHED; PG8_LDA(At, 0, 0); \
            if (!(REL)) { const char* a1 = PG8_PA(cur, t + 1); PG8_STA(PG8_SA(1, 1), a1 + 128u * cla, cla); PG8_WAIT_V(8); } \
            PG8_WAIT_L(0); PG8_BAR; PG8_MMA(0, 0, At, B0); PG8_MMA(0, 1, At, B1); PG8_BAR; PG8_SCHED; \
              \
            PG8_LDA(At, 0, 1); \
            { const char* a2 = last ? nA : PG8_PA(cur, t + 2); const char* b2 = last ? nB : PG8_PB(cur, t + 2); \
              PG8_STB(PG8_SB(0, 0), b2, lb2); PG8_STB(PG8_SB(0, 1), b2 + 128u * lb2, lb2); PG8_STA(PG8_SA(0, 0), a2, la2); } \
            if (!(REL)) PG8_WAIT_V(8); \
            PG8_WAIT_L(0); PG8_BAR; PG8_MMA(1, 0, At, B0); PG8_MMA(1, 1, At, B1); PG8_BAR; PG8_SCHED; \
              \
            PG8_LDB(B0, 1, 0); PG8_LDB(B1, 1, 1); PG8_SCHED; PG8_LDA(At, 1, 0); \
            { const char* a2 = last ? nA : PG8_PA(cur, t + 2); PG8_STA(PG8_SA(0, 1), a2 + 128u * la2, la2); } \
            if (!(REL)) PG8_WAIT_V(8); \
            PG8_WAIT_L(0); PG8_BAR; PG8_MMA(0, 0, At, B0); PG8_MMA(0, 1, At, B1); PG8_BAR; PG8_SCHED; \
              \
            PG8_LDA(At, 1, 1); \
            { const char* a3 = last ? nA + 128 : PG8_PA(cur, t + 3); const char* b3 = last ? nB + 128 : PG8_PB(cur, t + 3); \
              PG8_STB(PG8_SB(1, 0), b3, lb2); PG8_STB(PG8_SB(1, 1), b3 + 128u * lb2, lb2); PG8_STA(PG8_SA(1, 0), a3, la2); } \
            PG8_WAIT_V(8); PG8_WAIT_L(0); PG8_BAR; PG8_MMA(1, 0, At, B0); PG8_MMA(1, 1, At, B1); PG8_BAR; PG8_SCHED; } while (0)
    for (;;) {
        const char* nA; const char* nB; unsigned nla, nlb; bool has_next;
        { Unit nx; has_next = S.next(ui + 1, nx); if (!has_next) nx = cur;
          nA = nx.A; nB = nx.B; nla = nx.lda; nlb = nx.ldb; }
        const int nt = cur.nt(); const unsigned cla = cur.lda, clb = cur.ldb;
        PG8_BODY(0, true);
        for (int tt = 2; tt < nt; tt += 2) PG8_BODY(tt, false);
        if (wr == 0) PG8_BAR;
        { const char* nA1 = nA; asm volatile("" : "+s"(nA1));
          PG8_STA(PG8_SA(1, 1), nA1 + 128 + 128u * nla, nla); }
        E(acc, cur, wr, wc, fr, fq, lds);
        if (!has_next) break;
        if (!cur.keep()) {
#pragma unroll
            for (int a = 0; a < 2; ++a)
#pragma unroll
                for (int b = 0; b < 2; ++b)
#pragma unroll
                    for (int m = 0; m < 4; ++m)
#pragma unroll
                        for (int n = 0; n < 2; ++n) acc[a][b][m][n] = (f32x4){0.f, 0.f, 0.f, 0.f};
        }
        ++ui; (void)S.next(ui, cur);
        if (wr == 1) PG8_BAR;
    }
#undef PG8_BODY
    PG8_WAIT_V(0);
    PG8_BAR;
#undef PG8_SA
#undef PG8_SB
#undef PG8_STAGE
#undef PG8_STA
#undef PG8_STB
#undef PG8_LDA
#undef PG8_LDB
#undef PG8_MMA
#undef PG8_WAIT_V
#undef PG8_WAIT_L
#undef PG8_BAR
#undef PG8_SCHED
#undef PG8_PA
#undef PG8_PB
}
}
using pg8::Unit;

template <int PH> struct Sched {
    static constexpr int ph = PH; int G, c; Bufs b; int ibeg, iend;
    __device__ __forceinline__ unsigned start_delay() const {
        return 0u;
    }
    __device__ __forceinline__ bool next(int i, Unit& u) const {
        u.lda = 2048; u.ldb = 2048;
        if constexpr (PH == 1) {
            const int ii = i + ibeg; if (ii >= iend) return false;
            const int x = c & 7, li = ii * (G >> 3) + (c >> 3); if (li >= 442) return false;
            int pm, pn;
            if (li < 26) { const int s_ = li * 8 + x, q = s_ >> 2; pm = 64 + (s_ & 3); pn = q < 16 ? q : (q < 24 ? q + 16 : (q < 40 ? q - 8 : q)); }
            else { const int lp = li - 26; pm = 8 * x + (lp & 7); pn = lp >> 3; }
            const char* hrow = (const char*)b.H() + (size_t)pm * 256 * 2048; const char* wrow = (const char*)b.Win() + (size_t)pn * 256 * 2048;
            u.A = hrow; u.B = wrow; int kind;
            if (pn < 4) kind = pg8::K_RQ; else if (pn < 8) kind = pg8::K_RK;
            else if (pn < 12) { if (pm < 64) { kind = pg8::K_RVT; u.A = wrow; u.B = hrow; } else kind = pg8::K_RV; }
            else if (pn < 16) kind = pg8::K_RG; else if (pn < 24) kind = pg8::K_CA; else if (pn < 32) kind = pg8::K_CB;
            else if (pn < 36) kind = pg8::K_MQ; else if (pn < 40) kind = pg8::K_MG; else kind = pg8::K_GL;
            u.set(kind, pm, pn);
            return true;
        }
        if constexpr (PH == 20) {
            if (c >= 32 || i >= 8) return false;
            const int bh = (c & 7) * 4 + (c >> 3);
            u.set(pg8::K_CHAIN, bh, i, 4, 0, i < 7 ? 1 : 0); u.lda = 4096; u.ldb = 4096;
            u.A = (const char*)b.Vt() + ((size_t)bh * 256 * 2048 + (size_t)i * 256) * 2; u.B = (const char*)b.KTt() + ((size_t)bh * 256 * 2048 + (size_t)i * 256) * 2; return true;
        }
        if constexpr (PH == 23) {
            if (c < 80 || c >= 144 || i > 0) return false;
            const int j = c - 80, bb = j & 7, pn = j >> 3;
            const char* mrow = (const char*)b.MN() + (size_t)bb * 256 * 2048; const char* wrow = (const char*)b.Wmkv() + (size_t)pn * 256 * 2048;
            if (pn < 4) { u.set(pg8::K_MK, bb, pn); u.A = mrow; u.B = wrow; } else { u.set(pg8::K_MVT, bb, pn); u.A = wrow; u.B = mrow; }
            return true;
        }
        if constexpr (PH == 21 || PH == 22) {
            int L = -1;
            if constexpr (PH == 21) { if (c >= 80 && c < 144 && i < 4) { const int q = ((c - 80) >> 3) * 4 + i; L = (((c & 7) * 4 + (q >> 3)) << 3) | (q & 7); } }
            else { int q = -1; if (c >= 144) { if (i < 2) q = ((c - 144) >> 3) * 2 + i; } else if (c >= 48 && c < 80) { if (i == 0) q = 28 + ((c - 48) >> 3); } if (q >= 0) L = (((c & 7) * 4 + (q >> 3)) << 3) | (q & 7); }
            if (L < 0) return false;
            const int bh = L >> 3, cc = L & 7, bb = bh >> 2, h = bh & 3;
            const size_t off = ((size_t)(bb * SEQ + cc * 256) * D + h * 256) * 2;
            if constexpr (PH == 21) { u.set(pg8::K_QK, bh, cc, 4); u.A = (const char*)b.Q() + off; u.B = (const char*)b.KT() + off; }
            else { u.set(pg8::K_XS, bh, cc, 4); u.A = (const char*)b.MQ() + off; u.B = (const char*)b.MKb() + ((size_t)(bb * 256) * D + h * 256) * 2; }
            return true;
        }
        if constexpr (PH == 30 || PH == 31) {
            int L = i * G + c;
            if constexpr (PH == 30) { if (i == 0 && G == 256) L = (((c & 7) * 4 + (c >> 6)) << 3) | ((c >> 3) & 7); }
            if constexpr (PH == 31) { L = 256; { int q = -1; if (c >= 144) { if (i < 2) q = ((c - 144) >> 3) * 2 + i; } else if (c >= 48 && c < 80) { if (i == 0) q = 28 + ((c - 48) >> 3); } if (q >= 0) L = (((c & 7) * 4 + (q >> 3)) << 3) | (q & 7); } }
            if (L >= 256) return false;
            const int bh = L >> 3, cc = L & 7, bb = bh >> 2, h = bh & 3;
            const size_t off = ((size_t)(bb * SEQ + cc * 256) * D + h * 256) * 2;
            if constexpr (PH == 30) { u.set(pg8::K_RETO, bh, cc, cc == 0 ? 4 : 8); u.ldb = 4096;
                u.A = (const char*)b.H() + off; u.B = (const char*)b.Vt() + ((size_t)bh * 256 * 2048 + (size_t)cc * 256) * 2; }
            else { u.set(pg8::K_XO, bh, cc, 4); u.ldb = 512; u.A = (const char*)b.MQ() + off; u.B = (const char*)b.MVt() + (size_t)bh * 256 * 256 * 2; }
            return true;
        }
        if constexpr (PH == 24) {
            if (i > 0 || c < 32 || c >= 80) return false;
            const int j = c - 32, s_ = j & 15, br = j >> 4, pm = 64 + (s_ >> 2), pn = s_ & 3;
            u.set(pg8::K_P3S, pm, pn, 16, br, 0);
            const bf16* a = br == 0 ? b.Q() : (br == 1 ? b.GCB() : b.MQ()); const bf16* w = br == 0 ? b.Wro() : (br == 1 ? b.Wco() : b.Wmo());
            u.A = (const char*)a + (size_t)pm * 256 * 2048; u.B = (const char*)w + (size_t)pn * 256 * 2048; return true;
        }
        if constexpr (PH == 4) {
            if (i < 3) { const int x = c & 7, idx = c >> 3, pm = x * 8 + (idx >> 2), pn = idx & 3, br = i;
                u.set(pg8::K_P3A, pm, pn, 16, br, br < 2 ? 1 : 0);
                const bf16* a = br == 0 ? b.Q() : (br == 1 ? b.GCB() : b.MQ()); const bf16* w = br == 0 ? b.Wro() : (br == 1 ? b.Wco() : b.Wmo());
                u.A = (const char*)a + (size_t)pm * 256 * 2048; u.B = (const char*)w + (size_t)pn * 256 * 2048; return true; }
            return false;
        }
        if constexpr (PH == 5 || PH == 52) {
            if (i > 0) return false;
            if (PH == 52 && (c < 32 || c >= 48)) return false;
            const int x = c & 7, idx = c >> 3, pm = PH == 52 ? 64 + ((c - 32) >> 2) : x * 8 + (idx >> 2), pn = PH == 52 ? (c & 3) : (idx & 3);
            u.set(pg8::K_P3B, pm, pn, 16, 0);
            u.A = (const char*)b.H() + (size_t)pm * 256 * 2048; u.B = (const char*)b.Wout() + (size_t)pn * 256 * 2048;
            return true;
        }
        return false;
    }
};

template <int PH, bool DRY = false> struct Epi {
    Bufs bufs; int rt_dry;
    typedef f32x4 Acc[2][2][4][2];
#define EROW(ai, m) (128 * (ai) + 64 * wr + 16 * (m) + fr)
#define EPI_SEQ() do { asm volatile("" ::: "memory"); __builtin_amdgcn_sched_barrier(0); } while (0)
#define EPI_LANDED(n) do { asm volatile("s_waitcnt vmcnt(" #n ")" ::: "memory"); __builtin_amdgcn_sched_barrier(0); } while (0)
#define EPI_FENCE() do { asm volatile("s_waitcnt vmcnt(0)" ::: "memory"); __builtin_amdgcn_sched_barrier(0); } while (0)
#define EPI_LOOP_AM _Pragma("unroll") for (int ai = 0; ai < 2; ++ai) _Pragma("unroll") for (int m = 0; m < 4; ++m)
#define EPI_STEP() do { asm volatile("" ::: "memory"); __builtin_amdgcn_sched_barrier(0); } while (0)
    static __device__ __forceinline__ f32x4 bits4(u32x4 w) { return __builtin_bit_cast(f32x4, w); }
    static __device__ __forceinline__ u32x4 ubits4(f32x4 w) { return __builtin_bit_cast(u32x4, w); }
    template <bool NT = false> __device__ __forceinline__ void store_packed(const Acc& acc, bf16* base, size_t ld, int wr, int wc, int fr, int fq) const {
        const int cl = 32 * wc + 8 * fq;
        EPI_LOOP_AM { EPI_STEP(); bf16* rowp = base + (size_t)EROW(ai, m) * ld + cl;
#pragma unroll
            for (int bj = 0; bj < 2; ++bj) { if (NT) __builtin_nontemporal_store(ubits4(acc[ai][bj][m][0]), (u32x4*)(rowp + 128 * bj)); else *(u32x4*)(rowp + 128 * bj) = ubits4(acc[ai][bj][m][0]); } }
    }
    template <bool ISK> __device__ __forceinline__ void rope(const Bufs& b, Acc& acc, const Unit& u, int wr, int wc, int fr, int fq) const {
        const int head = u.pn() & 3, cl = 32 * wc + 8 * fq; const float ch = b.clg(head); const bool prompt = u.pm() < 64;
#pragma unroll
        for (int am = 0; am < 4; ++am) { EPI_STEP();
            const int ai = am >> 1; f32x4 cs[2][4];
#pragma unroll
            for (int mm = 0; mm < 2; ++mm) { const int m = 2 * (am & 1) + mm; const int r = u.pm() * 256 + EROW(ai, m); const int pidx = prompt ? (r & (SEQ - 1)) : SEQ + (r & 7);
                const float* cp = b.cosT() + pidx * 128 + cl; const float* sp = b.sinT() + pidx * 128 + cl;
                cs[mm][0] = *(const f32x4*)cp; cs[mm][1] = *(const f32x4*)(cp + 4); cs[mm][2] = *(const f32x4*)sp; cs[mm][3] = *(const f32x4*)(sp + 4); }
#pragma unroll
            for (int mm = 0; mm < 2; ++mm) { const int m = 2 * (am & 1) + mm; const int r = u.pm() * 256 + EROW(ai, m);
                const f32x4 c0 = cs[mm][0], c1 = cs[mm][1], s0 = cs[mm][2], s1 = cs[mm][3];
                const f32x4 x1a = acc[ai][0][m][0], x1b = acc[ai][0][m][1], x2a = acc[ai][1][m][0], x2b = acc[ai][1][m][1];
                f32x4 o1a = x1a * c0 - x2a * s0, o1b = x1b * c1 - x2b * s1, o2a = x1a * s0 + x2a * c0, o2b = x1b * s1 + x2b * c1;
                if (ISK) { float sc = 0.0625f; if (prompt) sc *= __builtin_amdgcn_exp2f((float)((r & 255) + 1) * ch); o1a *= sc; o1b *= sc; o2a *= sc; o2b *= sc; }
                acc[ai][0][m][0] = bits4(pack8(o1a, o1b)); acc[ai][1][m][0] = bits4(pack8(o2a, o2b)); }
        }
        EPI_SEQ();
        if (ISK && prompt) {
            EPI_LOOP_AM { EPI_STEP(); const int r = u.pm() * 256 + EROW(ai, m);
                const float s2 = __builtin_amdgcn_exp2f((float)((r & (SEQ - 1)) & ~255) * ch);
                bf16* t = b.KTt() + ((size_t)(((r >> 11) * 4 + head) * 256 + cl)) * SEQ + (r & (SEQ - 1));
#pragma unroll
                for (int bj = 0; bj < 2; ++bj) { f32x4 x0, x1; unpack8(ubits4(acc[ai][bj][m][0]), x0, x1); const u32x4 w = pack8(x0 * s2, x1 * s2);
#pragma unroll
                    for (int e = 0; e < 8; ++e) t[(size_t)(128 * bj + e) * SEQ] = (bf16)(w[e >> 1] >> (16 * (e & 1))); } }
        }
        store_packed<true>(acc, (ISK ? b.KT() : b.Q()) + (size_t)u.pm() * 256 * D + head * 256, D, wr, wc, fr, fq); EPI_LANDED(16);
    }
    template <int MODE, bool NT = false> __device__ __forceinline__ void store_tile(Acc& acc, bf16* base  , size_t ld, const float* bias, int wr, int wc, int fr, int fq) const {
        const int cl = 32 * wc + 8 * fq;
        f32x4 bv[2][2];
        if (MODE == 2) {
#pragma unroll
            for (int bj = 0; bj < 2; ++bj) { bv[bj][0] = *(const f32x4*)(bias + 128 * bj + cl); bv[bj][1] = *(const f32x4*)(bias + 128 * bj + cl + 4); } }
        EPI_LOOP_AM {
#pragma unroll
            for (int bj = 0; bj < 2; ++bj) { f32x4 v0 = acc[ai][bj][m][0], v1 = acc[ai][bj][m][1];
                if (MODE == 1) { v0 = silu4(v0); v1 = silu4(v1); }
                if (MODE == 2) { v0 = sigm4(v0 + bv[bj][0]); v1 = sigm4(v1 + bv[bj][1]);
#pragma unroll
                    for (int e = 0; e < 4; ++e) { v0[e] = fmaxf(v0[e], 7.8886090522101181e-31f); v1[e] = fmaxf(v1[e], 7.8886090522101181e-31f); } }
                acc[ai][bj][m][0] = bits4(pack8(v0, v1)); } }
        EPI_SEQ();
        if (MODE == 2) {
            EPI_LOOP_AM { EPI_STEP(); bf16* rowp = base + (size_t)EROW(ai, m) * ld + cl;
#pragma unroll
                for (int bj = 0; bj < 2; ++bj) __builtin_nontemporal_store(ubits4(acc[ai][bj][m][0]), (u32x4*)(rowp + 128 * bj)); }
            EPI_LANDED(16); return; }
        store_packed<NT>(acc, base, ld, wr, wc, fr, fq);
        EPI_LANDED(16);
    }
    __device__ __forceinline__ void operator()(Acc& acc, const Unit& u, int wr, int wc, int fr, int fq, LAS unsigned char* lds) const {
        asm volatile("" : "+v"(fr), "+v"(fq), "+s"(wr), "+s"(wc));
        if (DRY && rt_dry) { asm volatile("s_waitcnt vmcnt(0)" ::: "memory"); return; }
        Bufs b = bufs; asm volatile("" : "+s"(b.ka));
        const int cl = 32 * wc + 8 * fq;
        switch (u.kind()) {
        case pg8::K_RQ: if constexpr (PH == 1) { rope<false>(b, acc, u, wr, wc, fr, fq); } break;
        case pg8::K_RK: if constexpr (PH == 1) { rope<true>(b, acc, u, wr, wc, fr, fq); } break;
        case pg8::K_RV: if constexpr (PH == 1) { store_tile<0, true>(acc, b.Vs() + (size_t)(u.pm() * 256 - MP) * D + (u.pn() - 8) * 256, D, nullptr, wr, wc, fr, fq); } break;
        case pg8::K_RVT: if constexpr (PH == 1) { store_tile<0, true>(acc, b.Vt() + (size_t)(((u.pm() >> 3) * 4 + (u.pn() - 8)) * 256) * SEQ + (u.pm() & 7) * 256, SEQ, nullptr, wr, wc, fr, fq); } break;
        case pg8::K_RG: if constexpr (PH == 1) { store_tile<1, true>(acc, b.RG() + (size_t)u.pm() * 256 * D + (u.pn() - 12) * 256, D, nullptr, wr, wc, fr, fq); } break;
        case pg8::K_MQ: if constexpr (PH == 1) { store_tile<0>(acc, b.MQ() + (size_t)u.pm() * 256 * D + (u.pn() - 32) * 256, D, nullptr, wr, wc, fr, fq); } break;
        case pg8::K_MG: if constexpr (PH == 1) { store_tile<1>(acc, b.MG() + (size_t)u.pm() * 256 * D + (u.pn() - 36) * 256, D, nullptr, wr, wc, fr, fq); } break;
        case pg8::K_GL: if constexpr (PH == 1) { const int gi = u.pn() - 40; store_tile<2>(acc, b.GATES() + (size_t)(gi >> 2) * MT * D + (size_t)u.pm() * 256 * D + (gi & 3) * 256, D, b.b_gate() + gi * 256, wr, wc, fr, fq); } break;
        case pg8::K_CA: if constexpr (PH == 1) {
            const int t = u.pn() - 16;
            EPI_LOOP_AM { acc[ai][0][m][0] *= acc[ai][1][m][0]; acc[ai][0][m][1] *= acc[ai][1][m][1]; }
            EPI_SEQ();
            EPI_LOOP_AM { EPI_STEP(); const int r = u.pm() * 256 + EROW(ai, m);
                const f32x4 p0 = acc[ai][0][m][0], p1 = acc[ai][0][m][1];
                *(u32x4*)(b.PRE() + (size_t)r * D + 128 * t + cl) = pack8(p0, p1);
                float* st = nullptr;
                if (u.pm() < 64) { const int tt = r & (SEQ - 1); if (tt >= SEQ - 2) st = b.out + O_CP + (size_t)((r >> 11) * 2 + (tt - (SEQ - 2))) * D; }
                else { const int rs = r - MP, tt = rs & 7; if (tt >= 6) st = b.out + O_CS + (size_t)((rs >> 3) * 2 + (tt - 6)) * D; }
                if (st) { *(f32x4*)(st + 128 * t + cl) = p0; *(f32x4*)(st + 128 * t + cl + 4) = p1; } }
            EPI_LANDED(8);
        } break;
        case pg8::K_CB: if constexpr (PH == 1) {
            const int t = u.pn() - 24;
            EPI_LOOP_AM { acc[ai][0][m][0] = bits4(pack8(acc[ai][0][m][0] * silu4(acc[ai][1][m][0]), acc[ai][0][m][1] * silu4(acc[ai][1][m][1]))); }
            EPI_SEQ();
            EPI_LOOP_AM { EPI_STEP(); *(u32x4*)(b.GCB() + (size_t)(u.pm() * 256 + EROW(ai, m)) * D + 128 * t + cl) = ubits4(acc[ai][0][m][0]); }
            EPI_LANDED(8);
        } break;
        case pg8::K_MK: if constexpr (PH == 23) {
            EPI_FENCE();
            EPI_LOOP_AM { EPI_STEP(); const size_t ro = (size_t)(u.pm() * 256 + EROW(ai, m)) * D + u.pn() * 256 + cl;
#pragma unroll
                for (int bj = 0; bj < 2; ++bj) { const f32x4 v0 = acc[ai][bj][m][0], v1 = acc[ai][bj][m][1];
                    *(f32x4*)(b.out + O_MK + ro + 128 * bj) = v0; *(f32x4*)(b.out + O_MK + ro + 128 * bj + 4) = v1; *(u32x4*)(b.MKb() + ro + 128 * bj) = pack8(v0, v1); } }
        } break;
        case pg8::K_MVT: if constexpr (PH == 23) {
            const int h = u.pn() - 4;
            EPI_FENCE();
            EPI_LOOP_AM { EPI_STEP(); const int f = EROW(ai, m);
#pragma unroll
                for (int bj = 0; bj < 2; ++bj) { const f32x4 v0 = acc[ai][bj][m][0], v1 = acc[ai][bj][m][1]; const int mm = 128 * bj + cl;
                    *(u32x4*)(b.MVt() + (size_t)((u.pm() * 4 + h) * 256 + f) * 256 + mm) = pack8(v0, v1);
                    float* o = b.out + O_MV + (size_t)(u.pm() * 256 + mm) * D + h * 256 + f;
#pragma unroll
                    for (int e = 0; e < 4; ++e) { o[(size_t)e * D] = v0[e]; o[(size_t)(4 + e) * D] = v1[e]; } } }
        } break;
        case pg8::K_QK: if constexpr (PH == 21) {
            const int bh = u.pm(), bb = bh >> 2, h = bh & 3;
            EPI_LOOP_AM { const int il = EROW(ai, m);
#pragma unroll
                for (int bj = 0; bj < 2; ++bj) { f32x4 v0 = acc[ai][bj][m][0], v1 = acc[ai][bj][m][1]; const int j0 = 128 * bj + cl;
                    const int dd = il - j0;
#pragma unroll
                    for (int e = 0; e < 4; ++e) { v0[e] *= (float)min(max(dd - e + 1, 0), 1); v1[e] *= (float)min(max(dd - e - 3, 0), 1); }
                    acc[ai][bj][m][0] = bits4(pack8(v0, v1)); } }
            EPI_SEQ();
            store_packed(acc, b.H() + (size_t)(bb * SEQ + u.pn() * 256) * D + h * 256, D, wr, wc, fr, fq); EPI_LANDED(16);
        } break;
        case pg8::K_CHAIN: if constexpr (PH == 20) {
            const int bh = u.pm(), h = bh & 3, step = u.pn(); const float gs = __builtin_amdgcn_exp2f(-256.0f * (float)(step + 1) * b.clg(h));
            EPI_SEQ();
            EPI_LOOP_AM { EPI_STEP(); const int f = EROW(ai, m);
#pragma unroll
                for (int bj = 0; bj < 2; ++bj) { const f32x4 v0 = acc[ai][bj][m][0] * gs, v1 = acc[ai][bj][m][1] * gs; const int dk = 128 * bj + cl;
                    if (step < 7) *(u32x4*)(b.SALL() + (size_t)(bh * 256 + f) * SEQ + (step + 1) * 256 + dk) = pack8(v0, v1);
                    else { float* o = b.out + O_RP + (size_t)(bh * 256 + dk) * 256 + f;
#pragma unroll
                        for (int e = 0; e < 4; ++e) { o[(size_t)e * 256] = v0[e]; o[(size_t)(4 + e) * 256] = v1[e]; } } } }
            EPI_LANDED(16);
        } break;
        case pg8::K_RETO: if constexpr (PH == 30) {
            const int bh = u.pm(), bb = bh >> 2, h = bh & 3; const float ch = b.clg(h);
            LAS float* X = (LAS float*)(lds + LDS_X);
            const size_t tile0 = (size_t)(bb * SEQ + u.pn() * 256) * D + h * 256;
            EPI_LOOP_AM { const int il = EROW(ai, m); const float sc = __builtin_amdgcn_exp2f(-(float)(il + 1) * ch); float ss = 0.f;
#pragma unroll
                for (int bj = 0; bj < 2; ++bj)
#pragma unroll
                    for (int n = 0; n < 2; ++n) { f32x4 v = acc[ai][bj][m][n] * sc; acc[ai][bj][m][n] = v; ss += (v[0] * v[0] + v[1] * v[1]) + (v[2] * v[2] + v[3] * v[3]); }
                ss += __shfl_xor(ss, 16); ss += __shfl_xor(ss, 32);
                if (fq == 0) X[il * 4 + wc] = ss; }
            LDS_WAIT(); __builtin_amdgcn_s_barrier(); asm volatile("" ::: "memory");
#pragma unroll
            for (int ai = 0; ai < 2; ++ai) { EPI_STEP();
                u32x4 rg[4][2];
#pragma unroll
                for (int m = 0; m < 4; ++m)
#pragma unroll
                    for (int bj = 0; bj < 2; ++bj) rg[m][bj] = *(const u32x4*)(b.RG() + tile0 + (size_t)EROW(ai, m) * D + cl + 128 * bj);
#pragma unroll
                for (int m = 0; m < 4; ++m) { const int il = EROW(ai, m);
                    const f32x4 t = *(const LAS f32x4*)(X + il * 4); const float rs = __builtin_amdgcn_rsqf(((t[0] + t[1]) + (t[2] + t[3])) * (1.0f / 256.0f) + EPS);
#pragma unroll
                    for (int bj = 0; bj < 2; ++bj) { f32x4 r0, r1; unpack8(rg[m][bj], r0, r1);
                        acc[ai][bj][m][0] = bits4(pack8(acc[ai][bj][m][0] * rs * r0, acc[ai][bj][m][1] * rs * r1)); } } }
            EPI_SEQ();
            store_packed(acc, b.Q() + tile0, D, wr, wc, fr, fq); EPI_LANDED(16);
            LDS_WAIT(); __builtin_amdgcn_s_barrier(); asm volatile("" ::: "memory");
        } break;
        case pg8::K_XS: if constexpr (PH == 22) {
            const int bh = u.pm(), bb = bh >> 2, h = bh & 3; const float C = 0.0625f * LOG2E;
            LAS f32x2* X = (LAS f32x2*)(lds + LDS_X);
            float ml[2][4];
            EPI_LOOP_AM { EPI_STEP(); const int il = EROW(ai, m); float mx = -3.0e38f;
#pragma unroll
                for (int bj = 0; bj < 2; ++bj)
#pragma unroll
                    for (int n = 0; n < 2; ++n) { const f32x4 v = acc[ai][bj][m][n] * C; acc[ai][bj][m][n] = v; mx = fmaxf(fmaxf(mx, fmaxf(v[0], v[1])), fmaxf(v[2], v[3])); }
                mx = fmaxf(mx, __shfl_xor(mx, 16)); mx = fmaxf(mx, __shfl_xor(mx, 32)); float l = 0.f;
#pragma unroll
                for (int bj = 0; bj < 2; ++bj)
#pragma unroll
                    for (int n = 0; n < 2; ++n) { f32x4 v = acc[ai][bj][m][n];
#pragma unroll
                        for (int e = 0; e < 4; ++e) { v[e] = __builtin_amdgcn_exp2f(v[e] - mx); l += v[e]; }
                        acc[ai][bj][m][n] = v; }
                l += __shfl_xor(l, 16); l += __shfl_xor(l, 32); ml[ai][m] = mx;
                if (fq == 0) X[il * 4 + wc] = (f32x2){mx, l}; }
            LDS_WAIT(); __builtin_amdgcn_s_barrier(); asm volatile("" ::: "memory");
            EPI_LOOP_AM { EPI_STEP(); const int il = EROW(ai, m);
                const f32x2 t0 = X[il * 4 + 0], t1 = X[il * 4 + 1], t2 = X[il * 4 + 2], t3 = X[il * 4 + 3];
                const float M = fmaxf(fmaxf(t0.x, t1.x), fmaxf(t2.x, t3.x));
                const float L = t0.y * __builtin_amdgcn_exp2f(t0.x - M) + t1.y * __builtin_amdgcn_exp2f(t1.x - M) + t2.y * __builtin_amdgcn_exp2f(t2.x - M) + t3.y * __builtin_amdgcn_exp2f(t3.x - M);
                const float f = __builtin_amdgcn_exp2f(ml[ai][m] - M) * __builtin_amdgcn_rcpf(L);
#pragma unroll
                for (int bj = 0; bj < 2; ++bj) acc[ai][bj][m][0] = bits4(pack8(acc[ai][bj][m][0] * f, acc[ai][bj][m][1] * f)); }
            EPI_SEQ();
            store_packed(acc, b.MQ() + (size_t)(bb * SEQ + u.pn() * 256) * D + h * 256, D, wr, wc, fr, fq); EPI_LANDED(16);
            LDS_WAIT(); __builtin_amdgcn_s_barrier(); asm volatile("" ::: "memory");
        } break;
        case pg8::K_XO: if constexpr (PH == 31) {
            const int bh = u.pm(), bb = bh >> 2, h = bh & 3; const size_t tile0 = (size_t)(bb * SEQ + u.pn() * 256) * D + h * 256;
#pragma unroll
            for (int ai = 0; ai < 2; ++ai) { EPI_STEP();
                u32x4 mg[4][2];
#pragma unroll
                for (int m = 0; m < 4; ++m)
#pragma unroll
                    for (int bj = 0; bj < 2; ++bj) mg[m][bj] = *(const u32x4*)(b.MG() + tile0 + (size_t)EROW(ai, m) * D + cl + 128 * bj);
#pragma unroll
                for (int m = 0; m < 4; ++m)
#pragma unroll
                    for (int bj = 0; bj < 2; ++bj) { f32x4 g0, g1; unpack8(mg[m][bj], g0, g1);
                        acc[ai][bj][m][0] = bits4(pack8(acc[ai][bj][m][0] * g0, acc[ai][bj][m][1] * g1)); } }
            EPI_SEQ();
            store_packed(acc, b.MQ() + tile0, D, wr, wc, fr, fq); EPI_LANDED(16);
        } break;
        case pg8::K_P3A: if constexpr (PH == 4) {
            const int br = u.aux();
            const size_t tile0 = (size_t)u.pm() * 256 * D + u.pn() * 256;
            const bf16* gb = b.GATES() + (size_t)br * MT * D + tile0 + cl;
            if (br < 2) {
#pragma unroll
                for (int ai = 0; ai < 2; ++ai) { EPI_STEP();
                    u32x4 ga[4][2], gn[4][2];
#pragma unroll
                    for (int m = 0; m < 4; ++m)
#pragma unroll
                        for (int bj = 0; bj < 2; ++bj) { const bf16* gp = gb + (size_t)EROW(ai, m) * D + 128 * bj; ga[m][bj] = *(const u32x4*)gp; gn[m][bj] = *(const u32x4*)(gp + (size_t)MT * D); }
#pragma unroll
                    for (int m = 0; m < 4; ++m)
#pragma unroll
                        for (int bj = 0; bj < 2; ++bj) { f32x4 g0, g1, h0, h1; unpack8(ga[m][bj], g0, g1); unpack8(gn[m][bj], h0, h1);
#pragma unroll
                            for (int e = 0; e < 4; ++e) { g0[e] *= __builtin_amdgcn_rcpf(h0[e]); g1[e] *= __builtin_amdgcn_rcpf(h1[e]); }
                            acc[ai][bj][m][0] *= g0; acc[ai][bj][m][1] *= g1; } }
            } else {
                u32x4 ga[2][4][2];
                EPI_LOOP_AM {
#pragma unroll
                    for (int bj = 0; bj < 2; ++bj) ga[ai][m][bj] = *(const u32x4*)(gb + (size_t)EROW(ai, m) * D + 128 * bj); }
                EPI_LOOP_AM {
#pragma unroll
                    for (int bj = 0; bj < 2; ++bj) { f32x4 g0, g1; unpack8(ga[ai][m][bj], g0, g1); acc[ai][bj][m][0] = bits4(pack8(acc[ai][bj][m][0] * g0, acc[ai][bj][m][1] * g1)); } }
            }
            if (br < 2) { EPI_FENCE(); break; }
            EPI_SEQ();
            store_packed(acc, b.H() + tile0, D, wr, wc, fr, fq); EPI_LANDED(16);
        } break;
        case pg8::K_P3B: if constexpr (PH == 5 || PH == 52) {
            const int pm = u.pm(), pn = u.pn();
            const float* xb = pm < 64 ? b.xp() + (size_t)pm * 256 * D : b.xs() + (size_t)(pm - 64) * 256 * D;
            LAS float* X = (LAS float*)(lds + LDS_X);
#pragma unroll
            for (int ai = 0; ai < 2; ++ai) { EPI_STEP();
                f32x4 xv[4][2][2];
#pragma unroll
                for (int m = 0; m < 4; ++m) { const float* xr = xb + (size_t)EROW(ai, m) * D + pn * 256 + cl;
#pragma unroll
                    for (int bj = 0; bj < 2; ++bj) { xv[m][bj][0] = __builtin_nontemporal_load((const f32x4*)(xr + 128 * bj)); xv[m][bj][1] = __builtin_nontemporal_load((const f32x4*)(xr + 128 * bj + 4)); } }
#pragma unroll
                for (int m = 0; m < 4; ++m) { float ss = 0.f;
#pragma unroll
                    for (int bj = 0; bj < 2; ++bj)
#pragma unroll
                        for (int n = 0; n < 2; ++n) { const f32x4 v = acc[ai][bj][m][n] + xv[m][bj][n]; acc[ai][bj][m][n] = v; ss += (v[0] * v[0] + v[1] * v[1]) + (v[2] * v[2] + v[3] * v[3]); }
                    ss += __shfl_xor(ss, 16); ss += __shfl_xor(ss, 32);
                    if (fq == 0) X[EROW(ai, m) * 4 + wc] = ss; } }
            LDS_WAIT(); __builtin_amdgcn_s_barrier(); asm volatile("" ::: "memory");
            const int t = (wr * 4 + wc) * 64 + fq * 16 + fr;
            unsigned* cnt = b.ctl() + CW_PCNT + 16 * pm; float* part = (float*)(b.ctl() + CW_PART) + (size_t)pm * 1024;
            if (t < 256) { const f32x4 s4 = *(const LAS f32x4*)(X + t * 4); part[pn * 256 + t] = (s4[0] + s4[1]) + (s4[2] + s4[3]); }
            asm volatile("s_waitcnt vmcnt(0)" ::: "memory"); __builtin_amdgcn_s_barrier();
            if (t == 0) { __builtin_amdgcn_fence(__ATOMIC_RELEASE, "agent"); asm volatile("s_waitcnt vmcnt(0)" ::: "memory"); (void)__hip_atomic_fetch_add(cnt, 1u, __ATOMIC_RELAXED, __HIP_MEMORY_SCOPE_AGENT);
                unsigned sp = 0; while (__hip_atomic_load(cnt, __ATOMIC_RELAXED, __HIP_MEMORY_SCOPE_AGENT) < 4u && ++sp < (1u << 22)) __builtin_amdgcn_s_sleep(2);
                __builtin_amdgcn_fence(__ATOMIC_ACQUIRE, "agent"); asm volatile("s_waitcnt vmcnt(0)" ::: "memory"); }
            __builtin_amdgcn_s_barrier(); asm volatile("" ::: "memory");
            if (t < 256) { float s = 0.f;
#pragma unroll
                for (int j = 0; j < 4; ++j) s += __uint_as_float(__hip_atomic_load((unsigned*)part + j * 256 + t, __ATOMIC_RELAXED, __HIP_MEMORY_SCOPE_AGENT));
                X[1024 + t] = 1.0f / sqrtf(s * (1.f / D) + EPS); }
            LDS_WAIT(); __builtin_amdgcn_s_barrier(); asm volatile("" ::: "memory");
            f32x4 gg[2][2];
#pragma unroll
            for (int bj = 0; bj < 2; ++bj) { gg[bj][0] = *(const f32x4*)(b.fin_g() + pn * 256 + cl + 128 * bj); gg[bj][1] = *(const f32x4*)(b.fin_g() + pn * 256 + cl + 128 * bj + 4); }
            EPI_LOOP_AM { const float rs = X[1024 + EROW(ai, m)];
#pragma unroll
                for (int bj = 0; bj < 2; ++bj) { acc[ai][bj][m][0] = acc[ai][bj][m][0] * rs * gg[bj][0]; acc[ai][bj][m][1] = acc[ai][bj][m][1] * rs * gg[bj][1]; } }
            EPI_SEQ();
            float* dst = b.out + O_Y + (size_t)pm * 256 * D + pn * 256 + cl;
            EPI_LOOP_AM { EPI_STEP(); float* rowp = dst + (size_t)EROW(ai, m) * D;
#pragma unroll
                for (int bj = 0; bj < 2; ++bj) { __builtin_nontemporal_store(acc[ai][bj][m][0], (f32x4*)(rowp + 128 * bj)); __builtin_nontemporal_store(acc[ai][bj][m][1], (f32x4*)(rowp + 128 * bj + 4)); } }
            EPI_LANDED(16);
        } break;
        case pg8::K_P3S: if constexpr (PH == 24) {
            const int br = u.aux(); const size_t tile0 = (size_t)u.pm() * 256 * D + u.pn() * 256;
            const bf16* gb = b.GATES() + (size_t)br * MT * D + tile0 + cl;
            u32x4 ga[2][4][2];
            EPI_LOOP_AM {
#pragma unroll
                for (int bj = 0; bj < 2; ++bj) ga[ai][m][bj] = *(const u32x4*)(gb + (size_t)EROW(ai, m) * D + 128 * bj); }
            EPI_LOOP_AM {
#pragma unroll
                for (int bj = 0; bj < 2; ++bj) { f32x4 g0, g1; unpack8(ga[ai][m][bj], g0, g1); acc[ai][bj][m][0] = bits4(pack8(acc[ai][bj][m][0] * g0, acc[ai][bj][m][1] * g1)); } }
            EPI_SEQ();
            store_packed(acc, b.GS() + ((size_t)br * MS + (size_t)(u.pm() - 64) * 256) * D + u.pn() * 256, D, wr, wc, fr, fq); EPI_LANDED(16);
            volatile LAS unsigned* XI = (volatile LAS unsigned*)(lds + LDS_X);
            const int t = (wr * 4 + wc) * 64 + fq * 16 + fr, tix = (u.pm() - 64) * 4 + u.pn();
            asm volatile("s_waitcnt vmcnt(0)" ::: "memory"); __builtin_amdgcn_s_barrier();
            if (t == 0) { __builtin_amdgcn_fence(__ATOMIC_RELEASE, "agent"); asm volatile("s_waitcnt vmcnt(0)" ::: "memory");
                XI[0] = __hip_atomic_fetch_add(b.ctl() + CW_TCNT + tix, 1u, __ATOMIC_RELAXED, __HIP_MEMORY_SCOPE_AGENT); }
            LDS_WAIT(); __builtin_amdgcn_s_barrier(); asm volatile("" ::: "memory");
            if (XI[0] == 2u) {
                __builtin_amdgcn_fence(__ATOMIC_ACQUIRE, "agent"); asm volatile("s_waitcnt vmcnt(0)" ::: "memory");
                EPI_LOOP_AM {
#pragma unroll
                    for (int bj = 0; bj < 2; ++bj) { f32x4 a0, a1; unpack8(ubits4(acc[ai][bj][m][0]), a0, a1); acc[ai][bj][m][0] = a0; acc[ai][bj][m][1] = a1; } }
#pragma unroll
                for (int ob = 0; ob < 3; ++ob) { if (ob == br) continue;
                    const bf16* go = b.GS() + ((size_t)ob * MS + (size_t)(u.pm() - 64) * 256) * D + u.pn() * 256 + cl;
                    u32x4 w[2][4][2];
                    EPI_STEP();
                    EPI_LOOP_AM {
#pragma unroll
                        for (int bj = 0; bj < 2; ++bj) w[ai][m][bj] = *(const u32x4*)(go + (size_t)EROW(ai, m) * D + 128 * bj); }
                    EPI_LOOP_AM {
#pragma unroll
                        for (int bj = 0; bj < 2; ++bj) { f32x4 o0, o1; unpack8(w[ai][m][bj], o0, o1); acc[ai][bj][m][0] += o0; acc[ai][bj][m][1] += o1; } } }
                EPI_LOOP_AM {
#pragma unroll
                    for (int bj = 0; bj < 2; ++bj) acc[ai][bj][m][0] = bits4(pack8(acc[ai][bj][m][0], acc[ai][bj][m][1])); }
                EPI_SEQ();
                store_packed(acc, b.H() + tile0, D, wr, wc, fr, fq);
                asm volatile("s_waitcnt vmcnt(0)" ::: "memory"); __builtin_amdgcn_s_barrier();
                if (t == 0) { __builtin_amdgcn_fence(__ATOMIC_RELEASE, "agent"); asm volatile("s_waitcnt vmcnt(0)" ::: "memory");
                    (void)__hip_atomic_fetch_add(b.ctl() + CW_SCNT + 16 * (u.pm() - 64), 1u, __ATOMIC_RELAXED, __HIP_MEMORY_SCOPE_AGENT); }
            }
        } break;
        default: break;
        }
        if constexpr (PH == 1) {
            if (u.pm() >= 64 && u.pn() < 40) {
                asm volatile("s_waitcnt vmcnt(0)" ::: "memory"); __builtin_amdgcn_s_barrier();
                if (wr == 0 && wc == 0 && fr == 0 && fq == 0) { __builtin_amdgcn_fence(__ATOMIC_RELEASE, "agent"); asm volatile("s_waitcnt vmcnt(0)" ::: "memory"); (void)__hip_atomic_fetch_add(b.ctl() + CW_SREADY, 1u, __ATOMIC_RELAXED, __HIP_MEMORY_SCOPE_AGENT); }
            }
        }
    }
#undef EROW
#undef EPI_FENCE
#undef EPI_LOOP_AM
#undef EPI_STEP
};

#define XB_TMO      128
#define XB_XCNT(j)  (256  + 64 * (j))
#define XB_XSUB(j)  (1280 + 64 * (j))
#define XB_XGEN(j)  (2304 + 64 * (j))
#define XB_TOP      3328
#define XB_TOPGEN   3392
#define XCD_BAR_WORDS 3456
#define XB_SPIN_CAP (1u << 18)
__device__ __forceinline__ unsigned xb_ld(unsigned* p)              { return __hip_atomic_load(p, __ATOMIC_RELAXED, __HIP_MEMORY_SCOPE_AGENT); }
__device__ __forceinline__ unsigned xb_add(unsigned* p, unsigned v) { return __hip_atomic_fetch_add(p, v, __ATOMIC_RELAXED, __HIP_MEMORY_SCOPE_AGENT); }
__device__ __forceinline__ unsigned xb_xcc_id() { return (unsigned)__builtin_amdgcn_s_getreg((3 << 11) | 20) & 0xFu; }
#define XB_SPIN(cond, bar) do { unsigned _sp = 0; while (cond) { __builtin_amdgcn_s_sleep(1); \
    if ((++_sp & 255u) == 0u) { if (xb_ld(&(bar)[XB_TMO])) break; if (_sp > XB_SPIN_CAP) { atomicAdd(&(bar)[XB_TMO], 1u); break; } } } } while (0)
struct XcdBarrier { unsigned* bar; unsigned x; volatile LAS unsigned* st; };
__device__ __forceinline__ XcdBarrier xcd_barrier_post(unsigned* bar, volatile LAS unsigned* st) {
    XcdBarrier b; b.bar = bar; b.x = xb_xcc_id(); b.st = st;
    if (threadIdx.x == 0) (void)xb_add(&bar[XB_XCNT(b.x)], 1u);
    return b;
}
__device__ __forceinline__ void xcd_barrier_complete(unsigned* bar, unsigned x, unsigned& nloc, unsigned& nx) {
    const unsigned G = gridDim.x * gridDim.y * gridDim.z;
    unsigned sum, cnt, mine, sp = 0u;
    for (;;) {
        sum = 0u; cnt = 0u; mine = 0u;
#pragma unroll
        for (unsigned j = 0; j < 16; ++j) { const unsigned c = xb_ld(&bar[XB_XCNT(j)]); sum += c; cnt += (c > 0u) ? 1u : 0u; mine = (j == x) ? c : mine; }
        if (sum == G) break;
        __builtin_amdgcn_s_sleep(1);
        if ((++sp & 255u) == 0u) { if (xb_ld(&bar[XB_TMO])) break; if (sp > XB_SPIN_CAP) { atomicAdd(&bar[XB_TMO], 1u); break; } }
    }
    nloc = mine > 0u ? mine : 1u; nx = cnt > 0u ? cnt : 1u;
}
__device__ __forceinline__ void xcd_barrier(const XcdBarrier& b, unsigned* ready = nullptr) {
    asm volatile("s_waitcnt vmcnt(0)" ::: "memory");
    __syncthreads();
    if (threadIdx.x == 0) {
        unsigned* bar = b.bar;
        if (ready) {
            unsigned sp = 0; while (xb_ld(ready) != 1u && ++sp < (1u << 22)) __builtin_amdgcn_s_sleep(2);
            __builtin_amdgcn_fence(__ATOMIC_ACQUIRE, "agent"); asm volatile("s_waitcnt vmcnt(0)" ::: "memory");
            (void)xb_add(&bar[XB_XCNT(b.x)], 1u); }
        __builtin_amdgcn_s_waitcnt(0);
        unsigned nloc = b.st[0], nx = b.st[1];
        if (nloc == 0u) { xcd_barrier_complete(bar, b.x, nloc, nx); b.st[0] = nloc; b.st[1] = nx; }
        const unsigned old = xb_add(&bar[XB_XSUB(b.x)], 1u);
        const unsigned gen = old / nloc;
        if (old + 1u == (gen + 1u) * nloc) {
            __builtin_amdgcn_fence(__ATOMIC_RELEASE, "agent");
            asm volatile("s_waitcnt vmcnt(0)" ::: "memory");
            const unsigned og = xb_add(&bar[XB_TOP], 1u);
            const unsigned tg = og / nx;
            if (og + 1u == (tg + 1u) * nx) xb_add(&bar[XB_TOPGEN], 1u);
            else XB_SPIN(xb_ld(&bar[XB_TOPGEN]) == tg, bar);
            __builtin_amdgcn_fence(__ATOMIC_ACQUIRE, "agent");
            xb_add(&bar[XB_XGEN(b.x)], 1u);
            asm volatile("s_waitcnt vmcnt(0)" ::: "memory");
        } else {
            XB_SPIN(xb_ld(&bar[XB_XGEN(b.x)]) == gen, bar);
            __builtin_amdgcn_fence(__ATOMIC_ACQUIRE, "agent");
            asm volatile("s_waitcnt vmcnt(0)" ::: "memory");
        }
    }
    __syncthreads();
}

__device__ __forceinline__ void p0_transpose_item(const float* W, int K, int N, bf16* WT, int src_col0, int src_col1, int dst_row0, int k0, LAS float* scr, int lane, const float* kscale = nullptr) {
    const int c4 = (lane & 15) * 4, kr = lane >> 4;
    const float* src = W + (size_t)(k0 + kr) * N + (c4 < 32 ? src_col0 + c4 : src_col1 + (c4 - 32));
    f32x4 v[16];
#pragma unroll
    for (int i = 0; i < 16; ++i) v[i] = __builtin_nontemporal_load((const f32x4*)(src + (size_t)(4 * i) * N));
#pragma unroll
    for (int i = 0; i < 16; ++i) { const int kk = 4 * i + kr; f32x4 w = v[i]; if (kscale) w *= kscale[k0 + kk];
        LAS float* d = scr + kk * 65 + c4; d[0] = w[0]; d[1] = w[1]; d[2] = w[2]; d[3] = w[3]; }
    LDS_WAIT(); asm volatile("" ::: "memory");
    const int c = lane & 7;
#pragma unroll
    for (int j = 0; j < 8; ++j) { const int n = (lane >> 3) + 8 * j; const LAS float* s = scr + (8 * c) * 65 + n;
        u32x4 o; o.x = pk2(s[0 * 65], s[1 * 65]); o.y = pk2(s[2 * 65], s[3 * 65]); o.z = pk2(s[4 * 65], s[5 * 65]); o.w = pk2(s[6 * 65], s[7 * 65]);
        *(u32x4*)(WT + (size_t)(dst_row0 + n) * K + k0 + 8 * c) = o; }
    LDS_WAIT(); asm volatile("" ::: "memory");
}
__device__ __forceinline__ int win_src_col(int n) {
    const int tile = n >> 8, w = n & 255;
    if (tile >= 16 && tile < 24) { const int t = tile - 16; return w < 128 ? 4096 + 128 * t + w : 6144 + 128 * t + (w - 128); }
    if (tile >= 24 && tile < 32) { const int t = tile - 24; return w < 128 ? 5120 + 128 * t + w : 7168 + 128 * t + (w - 128); }
    return n;
}
__device__ __forceinline__ void rms_row_to_bf16(const float* xrow, const float* g, bf16* orow, int lane) {
    const float* xr = xrow + 8 * lane; const float* gr = g + 8 * lane;
    f32x4 v[4]; float s = 0.f;
#pragma unroll
    for (int j = 0; j < 4; ++j) { v[j] = __builtin_nontemporal_load((const f32x4*)(xr + 512 * (j >> 1) + 4 * (j & 1))); s += (v[j][0] * v[j][0] + v[j][1] * v[j][1]) + (v[j][2] * v[j][2] + v[j][3] * v[j][3]); }
    const float rstd = 1.0f / sqrtf(wave_sum(s) * (1.f / D) + EPS);
#pragma unroll
    for (int j = 0; j < 2; ++j) { const f32x4 g0 = *(const f32x4*)(gr + 512 * j), g1 = *(const f32x4*)(gr + 512 * j + 4);
        *(u32x4*)(orow + 8 * lane + 512 * j) = pack8(v[2 * j] * rstd * g0, v[2 * j + 1] * rstd * g1); }
}
__device__ __forceinline__ void sincos_d(double a, float& s, float& c) {
    const double TWO_OVER_PI = 0.63661977236758134308, PIO2_HI = 1.57079632679489655800e+00, PIO2_LO = 6.12323399573676603587e-17;
    const double q = rint(a * TWO_OVER_PI); double t = fma(-q, PIO2_HI, a); t = fma(-q, PIO2_LO, t);
    const double t2 = t * t;
    double sp = -1.0 / 1307674368000.0; sp = fma(sp, t2, 1.0 / 6227020800.0); sp = fma(sp, t2, -1.0 / 39916800.0); sp = fma(sp, t2, 1.0 / 362880.0); sp = fma(sp, t2, -1.0 / 5040.0); sp = fma(sp, t2, 1.0 / 120.0); sp = fma(sp, t2, -1.0 / 6.0); sp = fma(sp * t2, t, t);
    double cp = 1.0 / 20922789888000.0; cp = fma(cp, t2, -1.0 / 87178291200.0); cp = fma(cp, t2, 1.0 / 479001600.0); cp = fma(cp, t2, -1.0 / 3628800.0); cp = fma(cp, t2, 1.0 / 40320.0); cp = fma(cp, t2, -1.0 / 720.0); cp = fma(cp, t2, 1.0 / 24.0); cp = fma(cp, t2, -0.5); cp = fma(cp, t2, 1.0);
    const int qi = (int)((long long)q & 3);
    const double sr = (qi == 0) ? sp : (qi == 1) ? cp : (qi == 2) ? -sp : -cp;
    const double cr = (qi == 0) ? cp : (qi == 1) ? -sp : (qi == 2) ? -cp : sp;
    s = (float)sr; c = (float)cr;
}
__device__ __forceinline__ void p0_prologue(const Bufs& b, LAS unsigned char* lds, int vcu, int G, int wave, int lane, int tid) {
    LAS float* scr = (LAS float*)(lds + wave * 17408);
    const int gw = vcu * NWAVES + wave, NGW = G * NWAVES;
    constexpr int I_IN = 16 * (NIN / 64), I_SQ = 16 * 16, I_KV = 16 * 32, NITEMS = I_IN + 4 * I_SQ + I_KV;
    for (int it = gw; it < NITEMS; it += NGW) {
        int r = it;
        if (r < I_IN) { const int nb = r >> 4, kb = r & 15; p0_transpose_item(b.w_in(), D, NIN, b.Win(), win_src_col(nb * 64), win_src_col(nb * 64 + 32), nb * 64, kb * 64, scr, lane); continue; } r -= I_IN;
        if (r < 4 * I_SQ) { const int wsel = r / I_SQ, q = r % I_SQ, nb = q >> 4, kb = q & 15;
            const float* W = wsel == 0 ? b.w_ro() : wsel == 1 ? b.w_co() : wsel == 2 ? b.w_mo() : b.w_out(); bf16* WT = wsel == 0 ? b.Wro() : wsel == 1 ? b.Wco() : wsel == 2 ? b.Wmo() : b.Wout();
            p0_transpose_item(W, D, D, WT, nb * 64, nb * 64 + 32, nb * 64, kb * 64, scr, lane, wsel == 0 ? b.ret_g() : nullptr); continue; }
        r -= 4 * I_SQ;
        { const int nb = r >> 4, kb = r & 15; p0_transpose_item(b.w_mkv(), D, 2 * D, b.Wmkv(), nb * 64, nb * 64 + 32, nb * 64, kb * 64, scr, lane); }
    }
    for (int m = gw; m < MT; m += NGW) rms_row_to_bf16(m < MP ? b.xp() + (size_t)m * D : b.xs() + (size_t)(m - MP) * D, b.norm_g(), b.H() + (size_t)m * D, lane);
    for (int m = gw; m < NB * 256; m += NGW) rms_row_to_bf16(b.memp() + (size_t)m * D, b.memn_g(), b.MN() + (size_t)m * D, lane);
    for (int e = vcu * 512 + tid; e < NPOS * 128; e += G * 512) {
        const int p = e >> 7, j = e & 127; const double pos = p < SEQ ? (double)p : (double)(16384 + (p - SEQ));
        double inv = 1.0, bs = 0.93057204092969897916;
#pragma unroll
        for (int k = 0; k < 7; ++k) { if ((j >> k) & 1) inv *= bs; bs *= bs; }
        float s, c; sincos_d(pos * inv, s, c); b.cosT()[e] = c; b.sinT()[e] = s;
    }
}

__device__ __forceinline__ void ret_sample_unit(Bufs b, LAS unsigned char* lds, int bb, int h, int tid, int wave, int lane, int dry) {
    asm volatile("" : "+s"(b.ka));
    asm volatile("" : "+v"(tid), "+v"(lane));
    LAS float* qk = (LAS float*)lds;
    LAS float* red = (LAS float*)(lds + 16384);
    LAS float* Ap = (LAS float*)(lds + 16384 + 65536);
    const float ch = b.clg(h);
    const int r0 = MP + bb * DECS;
    const size_t sbase = (size_t)(bb * 4 + h) * 65536;
    int wrow = wave * 32; asm volatile("" : "+v"(wrow));
    const float* sin_ = b.state_ret() + sbase + 4 * lane + (size_t)wrow * 256; float* sout = b.out + O_RS + sbase + 4 * lane + (size_t)wrow * 256;
    f32x4 sA[8], sB[8];
#define RS_LOAD(buf, dd) do { _Pragma("unroll") for (int k = 0; k < 8; ++k) buf[k] = __builtin_nontemporal_load((const f32x4*)(sin_ + (size_t)((dd) + k) * 256)); } while (0)
    RS_LOAD(sA, 0);
    {
        const int row = tid & 15, dch = tid >> 4; const bf16* src = (row < 8 ? b.Q() : b.KT()) + (size_t)(r0 + (row & 7)) * D + h * 256 + dch * 8;
        f32x4 a0, a1; unpack8(*(const u32x4*)src, a0, a1); float sc = 1.f;
        if (row >= 8) sc = __builtin_amdgcn_exp2f(-(float)(7 - (row & 7)) * ch);
#pragma unroll
        for (int e = 0; e < 4; ++e) { qk[(dch * 8 + e) * 16 + row] = a0[e] * sc; qk[(dch * 8 + 4 + e) * 16 + row] = a1[e] * sc; }
    }
    f32x4 vv[8];
#pragma unroll
    for (int j = 0; j < 8; ++j) { const u32x2 w = *(const u32x2*)(b.Vs() + (size_t)(bb * DECS + j) * D + h * 256 + 4 * lane); vv[j] = (f32x4){bflo(w.x), bfhi(w.x), bflo(w.y), bfhi(w.y)}; }
    LDS_WAIT(); __syncthreads();
    f32x4 oacc[8];
#pragma unroll
    for (int i = 0; i < 8; ++i) oacc[i] = (f32x4){0.f, 0.f, 0.f, 0.f};
    const float g8 = __builtin_amdgcn_exp2f(-8.0f * ch);
#define RS_COMP(buf, dd) do { _Pragma("unroll") for (int k = 0; k < 8; ++k) { const int d = wave * 32 + (dd) + k; \
            const LAS f32x4* qr = (const LAS f32x4*)(qk + d * 16); const f32x4 q0 = qr[0], q1 = qr[1], k0 = qr[2], k1 = qr[3]; \
            f32x4 sn = buf[k] * g8; \
            _Pragma("unroll") for (int i = 0; i < 4; ++i) { oacc[i] += buf[k] * q0[i]; oacc[4 + i] += buf[k] * q1[i]; sn += vv[i] * k0[i]; sn += vv[4 + i] * k1[i]; } \
            if (!dry) __builtin_nontemporal_store(sn, (f32x4*)(sout + (size_t)((dd) + k) * 256)); } } while (0)
    RS_LOAD(sB, 8); RS_COMP(sA, 0); RS_LOAD(sA, 16); RS_COMP(sB, 8); RS_LOAD(sB, 24); RS_COMP(sA, 16); RS_COMP(sB, 24);
#undef RS_LOAD
#undef RS_COMP
#pragma unroll
    for (int i = 0; i < 8; ++i) *(LAS f32x4*)(red + (wave * 8 + i) * 256 + 4 * lane) = oacc[i];
    {
        const int i = lane >> 3, j = lane & 7; float s = 0.f;
#pragma unroll 8
        for (int d = wave * 32; d < wave * 32 + 32; ++d) s += qk[d * 16 + i] * qk[d * 16 + 8 + j];
        Ap[wave * 64 + lane] = s;
    }
    LDS_WAIT(); __syncthreads();
    {
        const int i = wave; f32x4 o = (f32x4){0.f, 0.f, 0.f, 0.f};
#pragma unroll
        for (int w = 0; w < 8; ++w) o += *(const LAS f32x4*)(red + (w * 8 + i) * 256 + 4 * lane);
        o *= __builtin_amdgcn_exp2f(-(float)(i + 1) * ch);
        const float gi7 = __builtin_amdgcn_exp2f((float)(7 - i) * ch);
#pragma unroll
        for (int j = 0; j < 8; ++j) { if (j <= i) { float a = 0.f;
#pragma unroll
                for (int w = 0; w < 8; ++w) a += Ap[w * 64 + i * 8 + j];
                o += vv[j] * (a * gi7); } }
        const float ss = wave_sum((o[0] * o[0] + o[1] * o[1]) + (o[2] * o[2] + o[3] * o[3]));
        const float rstd = 1.0f / sqrtf(ss * (1.0f / 256.0f) + EPS);
        const size_t ro = (size_t)(r0 + i) * D + h * 256 + 4 * lane;
        const u32x2 rw = *(const u32x2*)(b.RG() + ro); const f32x4 rg = (f32x4){bflo(rw.x), bfhi(rw.x), bflo(rw.y), bfhi(rw.y)};
        const f32x4 y = o * rstd * rg; u32x2 w; w.x = pk2(y[0], y[1]); w.y = pk2(y[2], y[3]);
        if (!dry) *(u32x2*)(b.Q() + ro) = w;
    }
    LDS_WAIT(); __syncthreads();
}
__device__ __forceinline__ void xattn_sample_unit(Bufs b, LAS unsigned char* lds, int bb, int h, int tid, int wave, int lane, int dry) {
    asm volatile("" : "+s"(b.ka));
    asm volatile("" : "+v"(tid), "+v"(lane));
    LAS float* sc = (LAS float*)lds;
    LAS float* pT = (LAS float*)(lds + 8192);
    LAS float* red = (LAS float*)(lds + 16384);
    const int r0 = MP + bb * DECS; const int fr = lane & 15, fq = lane >> 4;
    int wrow = wave * 32; asm volatile("" : "+v"(wrow));
    const float* vp = b.cmv() + ((size_t)(bb * 256) * 4 + h) * 256 + 4 * lane + (size_t)wrow * 1024;
    f32x4 vA[8], vB[8];
#define XV_LOAD(buf, mm) do { _Pragma("unroll") for (int k = 0; k < 8; ++k) buf[k] = __builtin_nontemporal_load((const f32x4*)(vp + (size_t)((mm) + k) * 1024)); } while (0)
    XV_LOAD(vA, 0);
    bf16x8 bq[8];
#pragma unroll
    for (int kk = 0; kk < 8; ++kk) { u32x4 w = (u32x4){0u, 0u, 0u, 0u}; if (fr < 8) w = *(const u32x4*)(b.MQ() + (size_t)(r0 + fr) * D + h * 256 + 32 * kk + 8 * fq); bq[kk] = __builtin_bit_cast(bf16x8, w); }
#pragma unroll
    for (int g = 0; g < 2; ++g) {
        const int key0 = (wave * 2 + g) * 16; const float* kp = b.cmk() + ((size_t)(bb * 256 + key0 + fr) * 4 + h) * 256 + 8 * fq;
        f32x4 ka[8][2];
#pragma unroll
        for (int kk = 0; kk < 8; ++kk) { ka[kk][0] = __builtin_nontemporal_load((const f32x4*)(kp + 32 * kk)); ka[kk][1] = __builtin_nontemporal_load((const f32x4*)(kp + 32 * kk + 4)); }
        f32x4 a4 = (f32x4){0.f, 0.f, 0.f, 0.f};
#pragma unroll
        for (int kk = 0; kk < 8; ++kk) { const u32x4 w = pack8(ka[kk][0], ka[kk][1]); a4 = __builtin_amdgcn_mfma_f32_16x16x32_bf16(__builtin_bit_cast(bf16x8, w), bq[kk], a4, 0, 0, 0); }
        if (fr < 8) {
#pragma unroll
            for (int r = 0; r < 4; ++r) sc[fr * 256 + key0 + 4 * fq + r] = a4[r] * (0.0625f * LOG2E);
        }
    }
    LDS_WAIT(); __syncthreads();
    {
        const int i = wave; const f32x4 s = *(const LAS f32x4*)(sc + i * 256 + 4 * lane);
        const float mx = wave_max(fmaxf(fmaxf(s[0], s[1]), fmaxf(s[2], s[3])));
        f32x4 e; float l = 0.f;
#pragma unroll
        for (int r = 0; r < 4; ++r) { e[r] = __builtin_amdgcn_exp2f(s[r] - mx); l += e[r]; }
        const float inv = 1.0f / wave_sum(l);
#pragma unroll
        for (int r = 0; r < 4; ++r) pT[(4 * lane + r) * 8 + i] = e[r] * inv;
    }
    LDS_WAIT(); __syncthreads();
    f32x4 oacc[8];
#pragma unroll
    for (int i = 0; i < 8; ++i) oacc[i] = (f32x4){0.f, 0.f, 0.f, 0.f};
#define XV_COMP(buf, mm) do { _Pragma("unroll") for (int k = 0; k < 8; ++k) { const LAS f32x4* pr = (const LAS f32x4*)(pT + (wave * 32 + (mm) + k) * 8); const f32x4 p0 = pr[0], p1 = pr[1]; \
            _Pragma("unroll") for (int i = 0; i < 4; ++i) { oacc[i] += buf[k] * p0[i]; oacc[4 + i] += buf[k] * p1[i]; } } } while (0)
    XV_LOAD(vB, 8); XV_COMP(vA, 0); XV_LOAD(vA, 16); XV_COMP(vB, 8); XV_LOAD(vB, 24); XV_COMP(vA, 16); XV_COMP(vB, 24);
#undef XV_LOAD
#undef XV_COMP
#pragma unroll
    for (int i = 0; i < 8; ++i) *(LAS f32x4*)(red + (wave * 8 + i) * 256 + 4 * lane) = oacc[i];
    LDS_WAIT(); __syncthreads();
    {
        const int i = wave; f32x4 o = (f32x4){0.f, 0.f, 0.f, 0.f};
#pragma unroll
        for (int w = 0; w < 8; ++w) o += *(const LAS f32x4*)(red + (w * 8 + i) * 256 + 4 * lane);
        const size_t ro = (size_t)(r0 + i) * D + h * 256 + 4 * lane;
        const u32x2 gw = *(const u32x2*)(b.MG() + ro); const f32x4 y = o * (f32x4){bflo(gw.x), bfhi(gw.x), bflo(gw.y), bfhi(gw.y)};
        u32x2 w; w.x = pk2(y[0], y[1]); w.y = pk2(y[2], y[3]);
        LDS_WAIT(); __syncthreads();
        if (!dry) *(u32x2*)(b.MQ() + ro) = w;
    }
}
__device__ __forceinline__ void conv_chunk(Bufs b, int chunk, int tid, int dry) {
    asm volatile("" : "+s"(b.ka));
    asm volatile("" : "+v"(tid));
    const int task = chunk * 512 + tid; constexpr int NPT = (MP / 16) * 128;
    int r0, nrows, t0; const float* st = nullptr;
    const int cg = task & 127, c0 = cg * 8;
    if (task < NPT) { const int run = task >> 7; r0 = run * 16; nrows = 16; t0 = r0 & (SEQ - 1); }
    else { const int run = (task - NPT) >> 7; r0 = MP + run * 8; nrows = 8; t0 = 0; st = b.state_conv() + (size_t)run * 2 * D + c0; }
    f32x4 w0a = *(const f32x4*)(b.conv_w() + c0), w0b = *(const f32x4*)(b.conv_w() + c0 + 4), w1a = *(const f32x4*)(b.conv_w() + D + c0), w1b = *(const f32x4*)(b.conv_w() + D + c0 + 4),
          w2a = *(const f32x4*)(b.conv_w() + 2 * D + c0), w2b = *(const f32x4*)(b.conv_w() + 2 * D + c0 + 4), ba = *(const f32x4*)(b.conv_b() + c0), bb_ = *(const f32x4*)(b.conv_b() + c0 + 4);
    f32x4 xm2a, xm2b, xm1a, xm1b;
    const f32x4 z = (f32x4){0.f, 0.f, 0.f, 0.f};
    if (t0 >= 2) { unpack8(*(const u32x4*)(b.PRE() + (size_t)(r0 - 2) * D + c0), xm2a, xm2b); unpack8(*(const u32x4*)(b.PRE() + (size_t)(r0 - 1) * D + c0), xm1a, xm1b); }
    else if (st) { xm2a = *(const f32x4*)st; xm2b = *(const f32x4*)(st + 4); xm1a = *(const f32x4*)(st + D); xm1b = *(const f32x4*)(st + D + 4); }
    else { xm2a = z; xm2b = z; xm1a = z; xm1b = z; }
#pragma unroll 4
    for (int k = 0; k < nrows; ++k) {
        const size_t ro = (size_t)(r0 + k) * D + c0;
        f32x4 xa, xb, ga, gb; unpack8(*(const u32x4*)(b.PRE() + ro), xa, xb); unpack8(*(const u32x4*)(b.GCB() + ro), ga, gb);
        const f32x4 ya = ga * (ba + w0a * xm2a + w1a * xm1a + w2a * xa), yb = gb * (bb_ + w0b * xm2b + w1b * xm1b + w2b * xb);
        if (!dry) *(u32x4*)(b.GCB() + ro) = pack8(ya, yb);
        xm2a = xm1a; xm2b = xm1b; xm1a = xa; xm1b = xb;
    }
}
constexpr int NSTREAM_RET = DECB * 4, NSTREAM_X = DECB * 4, NSTREAM_CONV = ((MP / 16) * 128 + DECB * 128) / 512;

__global__ void __launch_bounds__(NWAVES * 64, 2) fwd_kernel(Params p) {
    extern __shared__ __attribute__((aligned(16))) unsigned char lds_[];
    LAS unsigned char* lds = (LAS unsigned char*)lds_;
    volatile LAS unsigned* MISC = (volatile LAS unsigned*)(lds + LDS_MISC);
    const int wave = __builtin_amdgcn_readfirstlane((int)threadIdx.x >> 6);
#define LANE_ID() ((int)__builtin_amdgcn_mbcnt_hi(~0u, __builtin_amdgcn_mbcnt_lo(~0u, 0u)))
#define TID() (wave * 64 + LANE_ID())
    const int G = gridDim.x, bx = blockIdx.x, vcu = (G % 8 == 0) ? (bx % 8) * (G / 8) + bx / 8 : bx;
    Bufs b; b.ka = (kargp_t)__builtin_amdgcn_kernarg_segment_ptr(); b.ws = p.ws; b.out = p.out;
    if (wave == 0) MISC[LANE_ID()] = 0u;
    __syncthreads();
    if (bx == 0) { u32x4* z = (u32x4*)(b.ctl() + 4096) + TID();
#pragma unroll
        for (int k = 0; k < 4; ++k) z[512 * k] = (u32x4){0u, 0u, 0u, 0u};
        asm volatile("s_waitcnt vmcnt(0)" ::: "memory"); __syncthreads();
        if (wave == 0) { __builtin_amdgcn_fence(__ATOMIC_RELEASE, "agent"); asm volatile("s_waitcnt vmcnt(0)" ::: "memory"); __hip_atomic_store(b.ctl() + CW_READY, 1u, __ATOMIC_RELAXED, __HIP_MEMORY_SCOPE_AGENT); } }
    XcdBarrier bar; bar.bar = b.ctl() + CW_BAR; bar.x = xb_xcc_id(); bar.st = MISC + 8;

    const int lo = p.ph_lo, hi = p.ph_hi;
#ifndef PHMASK
#define PHMASK 0x7f
#endif
#define IN(k) (((PHMASK >> (k)) & 1) && lo <= (k) && (k) < hi)
#define SEAM(k) do { if (IN(k) && IN((k) + 1)) xcd_barrier(bar, (k) == 0 ? b.ctl() + CW_READY : nullptr); } while (0)
    constexpr int PROBE = PROBE_PHASE;
#define GEMM_PHASE(k, DRY) GEMM_PHASE_W(k, DRY, 0, 1 << 30)
#define GEMM_PHASE_W(k, DRY, IB, IE) do { Sched<k> S; S.G = G; S.c = bx; S.b = b; S.ibeg = (IB); S.iend = (IE); Epi<k, DRY> E; E.bufs = b; E.rt_dry = p.pad0; pg8::gemm_phase<Sched<k>, Epi<k, DRY>>(lds, S, E, wave); } while (0)
#define STREAM_PHASE(DRY) do { unsigned* qh = b.ctl() + CW_QUEUE + ((DRY) ? 64 : 0); const int lane = LANE_ID(), tid = wave * 64 + lane; \
        for (;;) { __syncthreads(); if (tid == 0) MISC[0] = __hip_atomic_fetch_add(qh, 1u, __ATOMIC_RELAXED, __HIP_MEMORY_SCOPE_AGENT); __syncthreads(); \
            const int item = (int)MISC[0]; if (item >= (MP / 16) * 128 / 512) break;     \
            conv_chunk(b, item, tid, (DRY) ? p.pad0 : 0); } } while (0)
    if (PROBE == 100) { p0_prologue(b, lds, vcu, G, wave, LANE_ID(), TID()); xcd_barrier(bar); }
    if (IN(0)) p0_prologue(b, lds, vcu, G, wave, LANE_ID(), TID());
    SEAM(0);
    if (PROBE == 101) { GEMM_PHASE(1, false); xcd_barrier(bar); }
    if (PROBE == 1) { GEMM_PHASE(1, true); xcd_barrier(bar); }
    if (IN(1)) {
        const int ksplit = 2 + ((bx >> 3) + 4 * (bx & 7)) % 11;
        GEMM_PHASE_W(1, false, 0, ksplit);
        { unsigned* sr = b.ctl() + CW_SREADY;
          if (TID() == 0) { unsigned sp = 0; while (xb_ld(sr) < 160u && ++sp < (1u << 22)) __builtin_amdgcn_s_sleep(4);
              __builtin_amdgcn_fence(__ATOMIC_ACQUIRE, "agent"); asm volatile("s_waitcnt vmcnt(0)" ::: "memory"); }
          __syncthreads();
          const int lane = LANE_ID(), tid = wave * 64 + lane;
          for (int k = 0; k < 2; ++k) { const int item = bx + 256 * k; if (item < NSTREAM_RET) ret_sample_unit(b, lds, item >> 2, item & 3, tid, wave, lane, 0); }
          for (int k = 0; k < 2; ++k) { const int item = bx + 256 * k; if (item < NSTREAM_X) xattn_sample_unit(b, lds, item >> 2, item & 3, tid, wave, lane, 0); }
          if (bx < 32) conv_chunk(b, (MP / 16) * 128 / 512 + bx, tid, 0);
          __syncthreads(); }
        GEMM_PHASE_W(1, false, ksplit, 1 << 30);
    }
    SEAM(1);
    if (PROBE == 20) { GEMM_PHASE(20, true); GEMM_PHASE(23, true); GEMM_PHASE(21, true); GEMM_PHASE(22, true); xcd_barrier(bar); }
    if (PROBE == 21) { STREAM_PHASE(1); xcd_barrier(bar); }
    if (IN(2)) {
        GEMM_PHASE(20, false);
        if (bx >= 32 && bx < 80) {
            GEMM_PHASE(24, false);
            if (bx < 48) {
                unsigned* sc = b.ctl() + CW_SCNT + 16 * ((bx - 32) >> 2);
                if (TID() == 0) { unsigned sp = 0; while (xb_ld(sc) < 4u && ++sp < (1u << 22)) __builtin_amdgcn_s_sleep(4);
                    __builtin_amdgcn_fence(__ATOMIC_ACQUIRE, "agent"); asm volatile("s_waitcnt vmcnt(0)" ::: "memory"); }
                __syncthreads();
                GEMM_PHASE(52, false);
            }
        }
        if (bx >= 48) {
            GEMM_PHASE(23, false);
            unsigned* mkd = b.ctl() + CW_MKDONE + 8 * (bx & 7);
            if (bx >= 80 && bx < 144 && TID() == 0) { __builtin_amdgcn_fence(__ATOMIC_RELEASE, "agent"); asm volatile("s_waitcnt vmcnt(0)" ::: "memory"); (void)xb_add(mkd, 1u); }
            GEMM_PHASE(21, false);
            if (bx >= 144 || bx < 80) {
            {
                unsigned* qh = b.ctl() + CW_QUEUE; const int lane = LANE_ID(), tid = wave * 64 + lane;
                for (;;) { __syncthreads();
                    if (tid == 0) { const unsigned done = xb_ld(mkd) >= 8u ? 1u : 0u; MISC[1] = done; MISC[0] = done ? 0u : __hip_atomic_fetch_add(qh, 1u, __ATOMIC_RELAXED, __HIP_MEMORY_SCOPE_AGENT); }
                    __syncthreads();
                    if (MISC[1]) break;
                    const int item = (int)MISC[0];
                    if (item >= (MP / 16) * 128 / 512) { if (tid == 0) { unsigned sp = 0; while (xb_ld(mkd) < 8u && ++sp < (1u << 22)) __builtin_amdgcn_s_sleep(4); } break; }
                    conv_chunk(b, item, tid, 0); }
                if (tid == 0) { __builtin_amdgcn_fence(__ATOMIC_ACQUIRE, "agent"); asm volatile("s_waitcnt vmcnt(0)" ::: "memory"); }
                __syncthreads(); }
            GEMM_PHASE(22, false);
            __builtin_amdgcn_fence(__ATOMIC_ACQUIRE, "agent"); __syncthreads();
            GEMM_PHASE(31, false);
            }
        }
        STREAM_PHASE(0);
    }
    SEAM(2);
    if (PROBE == 3) { GEMM_PHASE(30, true); GEMM_PHASE(31, true); xcd_barrier(bar); }
    if (IN(3)) GEMM_PHASE(30, false);
    SEAM(3);
    if (PROBE == 4) { GEMM_PHASE(4, true); xcd_barrier(bar); }
    if (IN(4)) GEMM_PHASE(4, false);
    SEAM(4);
    if (PROBE == 5) { GEMM_PHASE(5, true); xcd_barrier(bar); }
    if (IN(5)) GEMM_PHASE(5, false);
    if (bx == 0 && wave == 0) __hip_atomic_store(b.ctl() + CW_READY, 0u, __ATOMIC_RELAXED, __HIP_MEMORY_SCOPE_AGENT);
#undef IN
#undef SEAM
#undef GEMM_PHASE
#undef GEMM_PHASE_W
#undef STREAM_PHASE
#undef LANE_ID
#undef TID
}

#ifndef MK_N_LAUNCHES
#define MK_N_LAUNCHES 1
#endif
extern "C" void kernel_launch(void* const* d_in, const int* in_sizes, int n_in, void* d_out, int out_size, void* d_ws, size_t ws_size, hipStream_t stream) {
    static int grid = 0;
    if (grid == 0) {
        if (n_in != 20 || (size_t)out_size != O_END || ws_size < WS_END) { fprintf(stderr, "kernel_launch: unexpected shapes (n_in %d, out %d, ws %zu); nothing launched\n", n_in, out_size, ws_size); grid = -1; return; }
        int dev = 0, cus = 0, per_cu = 0;
        if (hipGetDevice(&dev) != hipSuccess || hipDeviceGetAttribute(&cus, hipDeviceAttributeMultiprocessorCount, dev) != hipSuccess) { grid = -1; return; }
        if (hipFuncSetAttribute((const void*)fwd_kernel, hipFuncAttributeMaxDynamicSharedMemorySize, LDS_BYTES) != hipSuccess) { fprintf(stderr, "kernel_launch: hipFuncSetAttribute failed\n"); grid = -1; return; }
        if (hipOccupancyMaxActiveBlocksPerMultiprocessor(&per_cu, (const void*)fwd_kernel, NWAVES * 64, LDS_BYTES) != hipSuccess || per_cu < 1) { fprintf(stderr, "kernel_launch: occupancy query says %d blocks per CU\n", per_cu); (void)hipGetLastError(); grid = -1; return; }
        grid = cus;
        if (grid != 256) { fprintf(stderr, "kernel_launch: built for a 256-CU device (the unit and sample-side work assignments are static in the CU index); found %d CUs; nothing launched\n", grid); grid = -1; return; }
    }
    if (grid < 0) return;
    Params p{};
    p.pad0 = (PROBE_PHASE >= 0 && PROBE_PHASE < 200) ? 1 : 0; p.pad1 = 0;
    for (int i = 0; i < 20; ++i) p.in[i] = (const float*)d_in[i];
    p.out = (float*)d_out; p.ws = (unsigned char*)d_ws + ((ws_size - WS_END) & ~((size_t)(2u << 20) - 1));
    for (int h = 0; h < 4; ++h) { const double g = 1.0 - std::exp2(-5.0 - (double)h); p.clog[h] = (float)(-std::log2(g)); }
    if (MK_N_LAUNCHES == 1) { p.ph_lo = 0; p.ph_hi = 7; hipLaunchKernelGGL(fwd_kernel, dim3(grid), dim3(NWAVES * 64), LDS_BYTES, stream, p);
#if PROBE_PHASE >= 200
        (void)hipMemsetAsync((char*)d_ws + WS_CTL, 0, CTL_ZERO_BYTES, stream); p.ph_lo = (PROBE_PHASE >= 400) ? (PROBE_PHASE - 400) / 10 : 0; p.ph_hi = (PROBE_PHASE >= 400) ? (PROBE_PHASE - 400) % 10 + 1 : PROBE_PHASE - 200 + 1; hipLaunchKernelGGL(fwd_kernel, dim3(grid), dim3(NWAVES * 64), LDS_BYTES, stream, p);
#endif
    }
    else for (int ph = 0; ph < 7; ++ph) { p.ph_lo = ph; p.ph_hi = ph + 1; hipLaunchKernelGGL(fwd_kernel, dim3(grid), dim3(NWAVES * 64), LDS_BYTES, stream, p); }
}
```
